# Optimizing an MI355X kernel written in HIP

```python
import math
import functools
import jax
import jax.numpy as jnp
from jax import lax
import numpy as np

D_MODEL = 2048
BATCH = 4
SEQ = 4096
DEPTH = 2

GRID_W = 64
CTX_LEN = 256
HEAD_DIM = 128
NA_HEADS = 3 * D_MODEL // (8 * HEAD_DIM)
NA_WIN_R = 8
NA_WIN_C = 16
SW_HEADS = 3 * D_MODEL // (8 * HEAD_DIM)
SW_KV_HEADS = SW_HEADS // 3
SW_WINDOW = 128
SW_BLOCK = 128
DF_V_DIM = 128
DF_QK_DIM = DF_V_DIM // 2
DF_HEADS = D_MODEL // (4 * DF_V_DIM)
DF_BLOCK = 128
MIX_WIDTH = NA_HEADS * HEAD_DIM + SW_HEADS * HEAD_DIM + DF_HEADS * DF_V_DIM
IN_WIDTHS = ((NA_HEADS * HEAD_DIM,) * 3
             + (SW_HEADS * HEAD_DIM, SW_KV_HEADS * HEAD_DIM, SW_KV_HEADS * HEAD_DIM)
             + (2 * DF_HEADS * DF_QK_DIM, 2 * DF_HEADS * DF_QK_DIM, DF_HEADS * DF_V_DIM))
IN_WIDTH = sum(IN_WIDTHS)
D_FF = 5632
N_EXPERTS = 8
TOP_K = 2
ROPE_THETA = 10000.0
NORM_EPS = 1e-6

kernel_name = 'hybrid_natten_swa_diff_moe_dit'


def rms_norm(x, g):
    xf = x.astype(jnp.float32)
    y = xf * lax.rsqrt(jnp.mean(xf * xf, axis=-1, keepdims=True) + NORM_EPS)
    return (y * g.astype(jnp.float32)).astype(x.dtype)


def modulate(h, shift, scale):
    return h * (1.0 + scale) + shift


def axial_rope_tables(n_tokens, head_dim):
    axis_dim = head_dim // 2
    inv_freq = ROPE_THETA ** (-jnp.arange(0, axis_dim, 2, dtype=jnp.float32) / axis_dim)
    t = jnp.arange(n_tokens, dtype=jnp.int32)
    row = (t // GRID_W).astype(jnp.float32)
    col = (t % GRID_W).astype(jnp.float32)
    ang_r = row[:, None] * inv_freq[None, :]
    ang_c = col[:, None] * inv_freq[None, :]
    return (jnp.cos(ang_r), jnp.sin(ang_r), jnp.cos(ang_c), jnp.sin(ang_c))


def _rotate_half(x, cos, sin):
    x1, x2 = jnp.split(x, 2, axis=-1)
    return jnp.concatenate([x1 * cos - x2 * sin, x2 * cos + x1 * sin], axis=-1)


def apply_axial_rope(x, tables):
    cos_r, sin_r, cos_c, sin_c = tables
    L = x.shape[1]
    shp = (L,) + (1,) * (x.ndim - 3) + (cos_r.shape[-1],)
    xr, xc = jnp.split(x.astype(jnp.float32), 2, axis=-1)
    out = jnp.concatenate([_rotate_half(xr, cos_r.reshape(shp), sin_r.reshape(shp)),
                           _rotate_half(xc, cos_c.reshape(shp), sin_c.reshape(shp))], axis=-1)
    return out.astype(x.dtype)


def project_heads(h, w_in):
    B, L, _ = h.shape
    p = h @ w_in
    offs = [0]
    for wdt in IN_WIDTHS:
        offs.append(offs[-1] + wdt)
    shapes = (((NA_HEADS, HEAD_DIM),) * 3
              + ((SW_HEADS, HEAD_DIM), (SW_KV_HEADS, HEAD_DIM), (SW_KV_HEADS, HEAD_DIM))
              + ((DF_HEADS, 2, DF_QK_DIM), (DF_HEADS, 2, DF_QK_DIM), (DF_HEADS, DF_V_DIM)))
    return tuple(p[..., offs[j]:offs[j + 1]].reshape((B, L) + shapes[j]) for j in range(len(shapes)))


def prepare_heads(h, w_in, norms, rope_b, rope_c):
    na_qg, na_kg, sw_qg, sw_kg, df_qg, df_kg = norms
    qa, ka, va, qb, kb, vb, qc, kc, vc = project_heads(h, w_in)
    qa, ka = rms_norm(qa, na_qg), rms_norm(ka, na_kg)
    qb, kb = rms_norm(qb, sw_qg), rms_norm(kb, sw_kg)
    qc, kc = rms_norm(qc, df_qg), rms_norm(kc, df_kg)
    if rope_b is not None:
        qb, kb = apply_axial_rope(qb, rope_b), apply_axial_rope(kb, rope_b)
        qc, kc = apply_axial_rope(qc, rope_c), apply_axial_rope(kc, rope_c)
    return qa, ka, va, qb, kb, vb, qc, kc, vc


def neighbourhood_attention(q, k, v, k_ctx, v_ctx, rpb):
    B, L, H, d = q.shape
    rows = L // GRID_W
    wr = min(NA_WIN_R, rows)
    wc = min(NA_WIN_C, GRID_W)
    scale = d ** -0.5
    qg = q.reshape(B, rows, GRID_W, H, d)
    kg = k.reshape(B, rows, GRID_W, H, d)
    vg = v.reshape(B, rows, GRID_W, H, d)
    col = jnp.arange(GRID_W)
    col_idx = jnp.clip(col - wc // 2, 0, GRID_W - wc)[:, None] + jnp.arange(wc)[None, :]
    ic = (col_idx - col[:, None] + NA_WIN_C - 1)[None]

    def one_row(r):
        r0 = jnp.clip(r - wr // 2, 0, rows - wr)
        q_r = lax.dynamic_index_in_dim(qg, r, axis=1, keepdims=False)
        k_nb = lax.dynamic_slice_in_dim(kg, r0, wr, axis=1)[:, :, col_idx]
        v_nb = lax.dynamic_slice_in_dim(vg, r0, wr, axis=1)[:, :, col_idx]
        ir = (r0 + jnp.arange(wr) - r + NA_WIN_R - 1)[:, None, None]
        bias = jnp.transpose(rpb[:, ir, ic], (0, 2, 1, 3)).astype(jnp.float32)
        s_nb = jnp.einsum('bqhd,brqkhd->bhqrk', q_r, k_nb).astype(jnp.float32) * scale + bias[None]
        s_cx = jnp.einsum('bqhd,bkhd->bhqk', q_r, k_ctx).astype(jnp.float32) * scale
        logits = jnp.concatenate([s_nb.reshape(B, H, GRID_W, wr * wc), s_cx], axis=-1)
        p = jax.nn.softmax(logits, axis=-1).astype(v.dtype)
        p_nb = p[..., :wr * wc].reshape(B, H, GRID_W, wr, wc)
        return (jnp.einsum('bhqrk,brqkhd->bqhd', p_nb, v_nb)
                + jnp.einsum('bhqk,bkhd->bqhd', p[..., wr * wc:], v_ctx))

    o = lax.map(one_row, jnp.arange(rows))
    return jnp.moveaxis(o, 0, 1).reshape(B, L, H, d)


def window_attention(q, k, v, k_ctx, v_ctx, sink):
    B, L, Hq, d = q.shape
    Hkv = k.shape[2]
    G = Hq // Hkv
    nb = L // SW_BLOCK
    Lc = k_ctx.shape[1]
    scale = d ** -0.5
    qb = q.reshape(B, nb, SW_BLOCK, Hkv, G, d)

    def band(t):
        pad = jnp.zeros((B, SW_BLOCK) + t.shape[2:], t.dtype)
        tp = jnp.concatenate([pad, t, pad], axis=1).reshape((B, nb + 2, SW_BLOCK) + t.shape[2:])
        return jnp.concatenate([tp[:, :-2], tp[:, 1:-1], tp[:, 2:]], axis=2)

    kb, vb = band(k), band(v)
    blk = jnp.arange(nb)[:, None]
    q_pos = blk * SW_BLOCK + jnp.arange(SW_BLOCK)[None, :]
    k_pos = (blk - 1) * SW_BLOCK + jnp.arange(3 * SW_BLOCK)[None, :]
    valid = (((k_pos >= 0) & (k_pos < L))[:, None, :]
             & (jnp.abs(q_pos[:, :, None] - k_pos[:, None, :]) <= SW_WINDOW))
    s_win = jnp.einsum('bnqhgd,bnkhd->bhgnqk', qb, kb).astype(jnp.float32) * scale
    s_win = jnp.where(valid, s_win, -jnp.inf)
    s_ctx = jnp.einsum('bnqhgd,bkhd->bhgnqk', qb, k_ctx).astype(jnp.float32) * scale
    s_sink = jnp.broadcast_to(sink.astype(jnp.float32).reshape(1, Hkv, G, 1, 1, 1), s_win.shape[:-1] + (1,))
    p = jax.nn.softmax(jnp.concatenate([s_win, s_ctx, s_sink], axis=-1), axis=-1).astype(v.dtype)
    nw = 3 * SW_BLOCK
    out = (jnp.einsum('bhgnqk,bnkhd->bnqhgd', p[..., :nw], vb)
           + jnp.einsum('bhgnqk,bkhd->bnqhgd', p[..., nw:nw + Lc], v_ctx))
    return out.reshape(B, L, Hq, d)


def context_attention(q, k, v, sink):
    B, Lc, Hq, d = q.shape
    Hkv = k.shape[2]
    G = Hq // Hkv
    qg = q.reshape(B, Lc, Hkv, G, d)
    s = jnp.einsum('bqhgd,bkhd->bhgqk', qg, k).astype(jnp.float32) * d ** -0.5
    if sink is not None:
        s_sink = jnp.broadcast_to(sink.astype(jnp.float32).reshape(1, Hkv, G, 1, 1), s.shape[:-1] + (1,))
        s = jnp.concatenate([s, s_sink], axis=-1)
    p = jax.nn.softmax(s, axis=-1)[..., :Lc].astype(v.dtype)
    return jnp.einsum('bhgqk,bkhd->bqhgd', p, v).reshape(B, Lc, Hq, d)


def diff_attention(q, k_all, v_all, lam):
    B, L, H, _, dk = q.shape
    nb = L // DF_BLOCK
    scale = dk ** -0.5
    qb = jnp.moveaxis(q.reshape(B, nb, DF_BLOCK, H, 2, dk), 1, 0)

    def one_block(q_blk):
        s = jnp.einsum('bqhtd,bkhtd->bhtqk', q_blk, k_all).astype(jnp.float32) * scale
        p = jax.nn.softmax(s, axis=-1)
        w = p[:, :, 0] - lam * p[:, :, 1]
        return jnp.einsum('bhqk,bkhd->bqhd', w.astype(v_all.dtype), v_all)

    o = lax.map(one_block, qb)
    return jnp.moveaxis(o, 0, 1).reshape(B, L, H, v_all.shape[-1])


def merge_head_groups(oa, ob, oc, w_out):
    B, L = oa.shape[:2]
    return jnp.concatenate([oa.reshape(B, L, -1), ob.reshape(B, L, -1), oc.reshape(B, L, -1)], axis=-1) @ w_out


def swiglu(h, w1, w3, w2):
    return (jax.nn.silu(h @ w1) * (h @ w3)) @ w2


def moe_swiglu(h, router, w1, w3, w2):
    logits = (h @ router).astype(jnp.float32)
    top_v, top_i = lax.top_k(logits, TOP_K)
    top_p = jax.nn.softmax(top_v, axis=-1)
    gates = jnp.sum(jax.nn.one_hot(top_i, N_EXPERTS, dtype=jnp.float32) * top_p[..., None], axis=-2).astype(h.dtype)
    y = jnp.zeros_like(h)
    for e in range(N_EXPERTS):
        y = y + gates[..., e:e + 1] * swiglu(h, w1[e], w3[e], w2[e])
    return y


def setup_inputs(seed: int = 0) -> dict:
    key = jax.random.key(seed)
    ks = jax.random.split(key, 27)
    f32 = jnp.float32
    n_dense = (DEPTH + 1) // 2
    n_moe = DEPTH // 2

    def nrm(k, shape, scale):
        return jax.random.normal(k, shape, f32) * scale

    def gain(k, shape):
        return 1.0 + nrm(k, shape, 0.05)

    return {
        'x': nrm(ks[0], (BATCH, SEQ, D_MODEL), 1.0),
        'c': nrm(ks[1], (BATCH, D_MODEL), 1.0),
        'ctx': nrm(ks[2], (BATCH, CTX_LEN, D_MODEL), 1.0),
        'c_ctx': nrm(ks[3], (D_MODEL,), 1.0),
        'ada_w': nrm(ks[4], (DEPTH, D_MODEL, 6 * D_MODEL), 0.5 * D_MODEL ** -0.5),
        'ada_b': nrm(ks[5], (DEPTH, 6 * D_MODEL), 0.02),
        'norm1_g': gain(ks[6], (DEPTH, D_MODEL)),
        'norm2_g': gain(ks[7], (DEPTH, D_MODEL)),
        'w_in': nrm(ks[8], (DEPTH, D_MODEL, IN_WIDTH), D_MODEL ** -0.5),
        'w_out': nrm(ks[9], (DEPTH, MIX_WIDTH, D_MODEL), MIX_WIDTH ** -0.5),
        'na_q_norm': gain(ks[10], (DEPTH, HEAD_DIM)),
        'na_k_norm': gain(ks[11], (DEPTH, HEAD_DIM)),
        'na_rpb': nrm(ks[12], (DEPTH, NA_HEADS, 2 * NA_WIN_R - 1, 2 * NA_WIN_C - 1), 0.1),
        'sw_q_norm': gain(ks[13], (DEPTH, HEAD_DIM)),
        'sw_k_norm': gain(ks[14], (DEPTH, HEAD_DIM)),
        'sw_sink': nrm(ks[15], (DEPTH, SW_HEADS), 0.5),
        'df_q_norm': gain(ks[16], (DEPTH, DF_QK_DIM)),
        'df_k_norm': gain(ks[17], (DEPTH, DF_QK_DIM)),
        'df_lambda': nrm(ks[18], (DEPTH, 4, DF_QK_DIM), 0.1),
        'df_subln_g': gain(ks[19], (DEPTH, DF_V_DIM)),
        'ffn_w1': nrm(ks[20], (n_dense, D_MODEL, D_FF), D_MODEL ** -0.5),
        'ffn_w3': nrm(ks[21], (n_dense, D_MODEL, D_FF), D_MODEL ** -0.5),
        'ffn_w2': nrm(ks[22], (n_dense, D_FF, D_MODEL), D_FF ** -0.5),
        'moe_router': nrm(ks[23], (n_moe, D_MODEL, N_EXPERTS), D_MODEL ** -0.5),
        'moe_w1': nrm(ks[24], (n_moe, N_EXPERTS, D_MODEL, D_FF), D_MODEL ** -0.5),
        'moe_w3': nrm(ks[25], (n_moe, N_EXPERTS, D_MODEL, D_FF), D_MODEL ** -0.5),
        'moe_w2': nrm(ks[26], (n_moe, N_EXPERTS, D_FF, D_MODEL), D_FF ** -0.5),
    }


def reference(x, c, ctx, c_ctx, ada_w, ada_b, norm1_g, norm2_g, w_in, w_out,
              na_q_norm, na_k_norm, na_rpb, sw_q_norm, sw_k_norm, sw_sink,
              df_q_norm, df_k_norm, df_lambda, df_subln_g,
              ffn_w1, ffn_w3, ffn_w2, moe_router, moe_w1, moe_w3, moe_w2):
    L = x.shape[1]
    rope_b = axial_rope_tables(L, HEAD_DIM)
    rope_c = axial_rope_tables(L, DF_QK_DIM)
    silu_c = jax.nn.silu(c)
    silu_cc = jax.nn.silu(c_ctx)[None]
    xc = ctx
    for i in range(DEPTH):
        last = i == DEPTH - 1
        mx = [m[:, None, :] for m in jnp.split(silu_c @ ada_w[i] + ada_b[i], 6, axis=-1)]
        mc = [m[:, None, :] for m in jnp.split(silu_cc @ ada_w[i] + ada_b[i], 6, axis=-1)]
        norms = (na_q_norm[i], na_k_norm[i], sw_q_norm[i], sw_k_norm[i], df_q_norm[i], df_k_norm[i])
        lq1, lk1, lq2, lk2 = df_lambda[i].astype(jnp.float32)
        lam_init = 0.8 - 0.6 * math.exp(-0.3 * i)
        lam = jnp.exp(jnp.sum(lq1 * lk1)) - jnp.exp(jnp.sum(lq2 * lk2)) + lam_init

        hx = modulate(rms_norm(x, norm1_g[i]), mx[0], mx[1])
        hc = modulate(rms_norm(xc, norm1_g[i]), mc[0], mc[1])
        qa, ka, va, qb, kb, vb, qc, kc, vc = prepare_heads(hx, w_in[i], norms, rope_b, rope_c)
        cqa, cka, cva, cqb, ckb, cvb, cqc, ckc, cvc = prepare_heads(hc, w_in[i], norms, None, None)
        oa = neighbourhood_attention(qa, ka, va, cka, cva, na_rpb[i])
        ob = window_attention(qb, kb, vb, ckb, cvb, sw_sink[i])
        oc = diff_attention(qc, jnp.concatenate([kc, ckc], axis=1), jnp.concatenate([vc, cvc], axis=1), lam)
        oc = rms_norm(oc, df_subln_g[i]) * (1.0 - lam_init)
        x = x + mx[2] * merge_head_groups(oa, ob, oc, w_out[i])

        j = i // 2
        if i % 2 == 0:
            ffn = functools.partial(swiglu, w1=ffn_w1[j], w3=ffn_w3[j], w2=ffn_w2[j])
        else:
            ffn = functools.partial(moe_swiglu, router=moe_router[j], w1=moe_w1[j], w3=moe_w3[j], w2=moe_w2[j])

        if not last:
            coa = context_attention(cqa, cka, cva, None)
            cob = context_attention(cqb, ckb, cvb, sw_sink[i])
            coc = rms_norm(diff_attention(cqc, ckc, cvc, lam), df_subln_g[i]) * (1.0 - lam_init)
            xc = xc + mc[2] * merge_head_groups(coa, cob, coc, w_out[i])
            xc = xc + mc[5] * ffn(modulate(rms_norm(xc, norm2_g[i]), mc[3], mc[4]))
        x = x + mx[5] * ffn(modulate(rms_norm(x, norm2_g[i]), mx[3], mx[4]))
    return x
```

```cpp
#include <hip/hip_runtime.h>
#include <cstdio>
#include <cstdint>

#ifndef MK_PER_PHASE
#define MK_PER_PHASE 0
#endif

#define GAS __attribute__((address_space(1)))
#define LAS __attribute__((address_space(3)))
typedef unsigned short bf16_t;
typedef short bf16x8 __attribute__((ext_vector_type(8)));
typedef short s16x4 __attribute__((ext_vector_type(4)));
typedef float f32x4 __attribute__((ext_vector_type(4)));
typedef float f32x2 __attribute__((ext_vector_type(2)));
typedef float f32x16 __attribute__((ext_vector_type(16)));
typedef unsigned u32x4 __attribute__((ext_vector_type(4)));
typedef unsigned u32x2 __attribute__((ext_vector_type(2)));

constexpr int D = 2048, NB = 4, SEQ = 4096, LAT = NB * SEQ, CTXL = 256, NCTX = NB * CTXL, R_ALL = LAT + NCTX;
constexpr int INW = 5120, FF = 5632, FF2 = 2 * FF, NE = 8;
constexpr int C_QA = 0, C_KA = 768, C_VA = 1536, C_QB = 2304, C_KB = 3072, C_VB = 3328, C_QC = 3584, C_KC = 4096, C_VC = 4608;
constexpr float NORM_EPS = 1e-6f, LOG2E = 1.4426950408889634f;
constexpr int MAXPAN = 136;

constexpr size_t MiB = 1u << 20;
constexpr size_t WS_CTL = 0, CTL_ZERO_BYTES = 1 * MiB;
constexpr size_t WS_MOD = 1 * MiB;
constexpr size_t WS_ROUTE_E = 2 * MiB;
constexpr size_t WS_ROUTE_P = WS_ROUTE_E + 65536;
constexpr size_t WS_SLOT_OF = WS_ROUTE_P + 131072;
constexpr size_t WS_GROW = WS_SLOT_OF + 131072;
constexpr size_t WS_PANE = WS_GROW + 262144;
constexpr size_t WS_XC = 3 * MiB;
constexpr size_t WS_WIN = WS_XC + 8 * MiB;
constexpr size_t WS_WOUT = WS_WIN + 40 * MiB;
constexpr size_t WS_W13 = WS_WOUT + 16 * MiB;
constexpr size_t WS_W2 = WS_W13 + 44 * MiB;
constexpr size_t WS_MW13 = WS_W2 + 22 * MiB;
constexpr size_t WS_MW2 = WS_MW13 + 352 * MiB;
constexpr size_t WS_H = WS_MW2 + 176 * MiB;
constexpr size_t WS_P = WS_H + 68 * MiB;
constexpr size_t WS_O = WS_P + 170 * MiB;
constexpr size_t WS_OC = WS_O + 68 * MiB;
constexpr size_t WS_Y = WS_P;
constexpr size_t WS_G = WS_OC + 68 * MiB;
constexpr size_t WS_END = WS_G + 374 * MiB;
static_assert((size_t)MAXPAN * 256 * D * 4 <= 306 * MiB, "Y overlay");
static_assert((size_t)MAXPAN * 256 * FF * 2 <= 374 * MiB, "G size");
constexpr int CW_BAR = 4096;
constexpr int CW_Q = 16384;

constexpr int RING_BYTES = 131072, LDSCTL_OFF = RING_BYTES, MISC_OFF = LDSCTL_OFF + 320, LDS_BYTES = 147456;

#define LDS_WAIT() asm volatile("s_waitcnt lgkmcnt(0)" ::: "memory")
#define VM_WAIT() asm volatile("s_waitcnt vmcnt(0)" ::: "memory")
#define RLX_AGENT __ATOMIC_RELAXED, __HIP_MEMORY_SCOPE_AGENT

__device__ __forceinline__ unsigned cvt_pk_bf16(float lo, float hi) { unsigned r; asm volatile("v_cvt_pk_bf16_f32 %0, %1, %2" : "=v"(r) : "v"(lo), "v"(hi)); return r; }
__device__ __forceinline__ float bf2f(unsigned short b) { return __uint_as_float(((unsigned)b) << 16); }
__device__ __forceinline__ unsigned short f2bf(float f) { unsigned u = __float_as_uint(f); return (unsigned short)((u + 0x7fffu + ((u >> 16) & 1u)) >> 16); }
template <int X> __device__ __forceinline__ float lane_xor(float v) {
    if constexpr (X == 1) return __builtin_bit_cast(float, __builtin_amdgcn_mov_dpp(__builtin_bit_cast(int, v), 0xB1, 0xF, 0xF, true));
    else if constexpr (X == 2) return __builtin_bit_cast(float, __builtin_amdgcn_mov_dpp(__builtin_bit_cast(int, v), 0x4E, 0xF, 0xF, true));
    else return __builtin_bit_cast(float, __builtin_amdgcn_ds_swizzle(__builtin_bit_cast(int, v), (X << 10) | 0x1f));
}
__device__ __forceinline__ float half_sum32(float v) {
    v += lane_xor<1>(v); v += lane_xor<2>(v); v += lane_xor<4>(v); v += lane_xor<8>(v); v += lane_xor<16>(v); return v;
}
__device__ __forceinline__ float wave_sum(float v) {
    v = half_sum32(v);
    auto rr = __builtin_amdgcn_permlane32_swap(__float_as_uint(v), __float_as_uint(v), false, false);
    return __uint_as_float(rr[0]) + __uint_as_float(rr[1]);
}

namespace pg8 {
constexpr int BM = 256, BK = 64, HALF = 128, HTB = HALF * BK * 2, STAGE_BYTES = 8 * HTB, NXCD = 8, WGM = 8;
__host__ __device__ __forceinline__ int lds_byte(int r, int c) { const int st = (r >> 4) * 2 + (c >> 5), rr = r & 15, cc = c & 31, ob = rr * 64 + cc * 2; return st * 1024 + (ob ^ (((ob >> 9) & 1) << 5)); }
__host__ __device__ __forceinline__ void stage_rc(int b, int& R, int& C) { const int st = b / 1024, sb = b % 1024, swz = sb ^ (((sb >> 9) & 1) << 5); R = (st >> 1) * 16 + swz / 64; C = (st & 1) * 32 + (swz % 64) / 2; }
__host__ __device__ __forceinline__ int perm32(int rho) { const int n = rho >> 4, i = rho & 15; return 8 * (i >> 2) + 4 * n + (i & 3); }

struct Unit { int pm, pn, e; };
struct Gemm { const bf16_t* A; const bf16_t* Bt; int N, K; const int* rowmap; };

struct StaticOrder {
    int nM, nN, nwg, G, c;
    __host__ __device__ void init(int M, int N, int G_, int c_) { nM = M / BM; nN = N / BM; nwg = nM * nN; G = G_; c = c_; }
    __host__ __device__ bool next(int i, Unit& u) const {
        const long L = (long)i * G + c; if (L >= nwg) return false;
        int wgid = (int)L; { const int q = nwg / NXCD, r = nwg % NXCD, xcd = wgid % NXCD, off = wgid / NXCD; wgid = (xcd < r ? xcd * (q + 1) : r * (q + 1) + (xcd - r) * q) + off; }
        const int nig = WGM * nN, gid = wgid / nig, fm = gid * WGM, gsz = (nM - fm) < WGM ? (nM - fm) : WGM;
        u.pm = fm + ((wgid % nig) % gsz); u.pn = (wgid % nig) / gsz; u.e = 0; return true;
    }
};
struct MoeOrder {
    int npan, nN, G, c; const int* pane;
    __device__ bool next(int i, Unit& u) const {
        const long L = (long)i * G + c; if (L >= (long)npan * nN) return false;
        u.pm = (int)(L / nN); u.pn = (int)(L % nN); u.e = __hip_atomic_load(pane + u.pm, __ATOMIC_RELAXED, __HIP_MEMORY_SCOPE_AGENT); return true;
    }
};

struct EpiBf16 {
    static constexpr bool PERM = true;
    bf16_t* O; int ldc;
    __device__ __forceinline__ void operator()(const f32x4 (&acc)[2][2][4][2], const Unit& u, int wr, int wc, int fr, int fq) const {
        const int row0 = u.pm * BM + wr * 64 + fr, col0 = u.pn * BM + wc * 32 + 8 * fq;
#pragma unroll
        for (int ai = 0; ai < 2; ++ai)
#pragma unroll
            for (int m = 0; m < 4; ++m) { bf16_t* rowp = O + (size_t)(row0 + ai * HALF + m * 16) * ldc + col0;
#pragma unroll
                for (int bj = 0; bj < 2; ++bj) { const f32x4 v0 = acc[ai][bj][m][0], v1 = acc[ai][bj][m][1];
                    u32x4 w; w.x = cvt_pk_bf16(v0[0], v0[1]); w.y = cvt_pk_bf16(v0[2], v0[3]); w.z = cvt_pk_bf16(v1[0], v1[1]); w.w = cvt_pk_bf16(v1[2], v1[3]);
                    *(u32x4*)(rowp + bj * HALF) = w; } }
    }
};
struct EpiF32 {
    static constexpr bool PERM = false;
    float* C; int ldc;
    __device__ __forceinline__ void operator()(const f32x4 (&acc)[2][2][4][2], const Unit& u, int wr, int wc, int fr, int fq) const {
        const int row0 = u.pm * BM + wr * 64 + fr, col0 = u.pn * BM + wc * 32 + 4 * fq;
#pragma unroll
        for (int ai = 0; ai < 2; ++ai)
#pragma unroll
            for (int m = 0; m < 4; ++m) { float* rowp = C + (size_t)(row0 + ai * HALF + m * 16) * ldc + col0;
#pragma unroll
                for (int bj = 0; bj < 2; ++bj)
#pragma unroll
                    for (int n = 0; n < 2; ++n) *(f32x4*)(rowp + bj * HALF + n * 16) = acc[ai][bj][m][n]; }
    }
};
struct EpiResGate {
    static constexpr bool PERM = false;
    const float* xin_lat; const float* xin_ctx; float* xout_lat; float* xout_ctx; const float* gate;
    __device__ __forceinline__ void operator()(const f32x4 (&acc)[2][2][4][2], const Unit& u, int wr, int wc, int fr, int fq) const {
        const bool isctx = u.pm >= (LAT / BM); const int b = isctx ? 4 : (u.pm >> 4);
        const int rowl = (isctx ? (u.pm - LAT / BM) : u.pm) * BM + wr * 64 + fr, col0 = u.pn * BM + wc * 32 + 4 * fq;
        const float* xi = isctx ? xin_ctx : xin_lat; float* xo = isctx ? xout_ctx : xout_lat; const float* gp = gate + (size_t)b * 12288 + col0;
#pragma unroll
        for (int bj = 0; bj < 2; ++bj)
#pragma unroll
            for (int n = 0; n < 2; ++n) { const f32x4 gv = *(const f32x4*)(gp + bj * HALF + n * 16);
#pragma unroll
                for (int ai = 0; ai < 2; ++ai) {
#pragma unroll
                    for (int m = 0; m < 4; ++m) { const size_t off = (size_t)(rowl + ai * HALF + m * 16) * D + col0 + bj * HALF + n * 16;
                        const f32x4 bs = *(const f32x4*)(xi + off); *(f32x4*)(xo + off) = bs + gv * acc[ai][bj][m][n]; }
                    asm volatile("" ::: "memory"); } }
    }
};
struct EpiSwiGLU {
    static constexpr bool PERM = false;
    bf16_t* G;
    __device__ __forceinline__ void operator()(const f32x4 (&acc)[2][2][4][2], const Unit& u, int wr, int wc, int fr, int fq) const {
        const int row0 = u.pm * BM + wr * 64 + fr, col0 = u.pn * 128 + wc * 16 + 4 * fq;
#pragma unroll
        for (int ai = 0; ai < 2; ++ai)
#pragma unroll
            for (int m = 0; m < 4; ++m) { bf16_t* rowp = G + (size_t)(row0 + ai * HALF + m * 16) * FF + col0;
#pragma unroll
                for (int bj = 0; bj < 2; ++bj) { const f32x4 a = acc[ai][bj][m][0], b = acc[ai][bj][m][1]; float r[4];
#pragma unroll
                    for (int j = 0; j < 4; ++j) { const float s = __builtin_amdgcn_rcpf(1.0f + __builtin_amdgcn_exp2f(-a[j] * LOG2E)); r[j] = a[j] * s * b[j]; }
                    u32x2 w; w.x = cvt_pk_bf16(r[0], r[1]); w.y = cvt_pk_bf16(r[2], r[3]);
                    *(u32x2*)(rowp + bj * 64) = w; } }
    }
};

template <class Epi, class Sched, bool GATHER, bool ALIGN_EPI = true>
__device__ __forceinline__ void gemm_phase(LAS unsigned char* lds, const Gemm g, const Sched& S, const Epi& E) {
    int tid = threadIdx.x; asm volatile("" : "+v"(tid));
    const int wid = __builtin_amdgcn_readfirstlane(tid >> 6), lane = tid & 63, wr = wid >> 2, wc = wid & 3, fr = lane & 15, fq = lane >> 4;
    const int K = g.K, nt = K / BK;
    int RA[2], CA[2]; unsigned voffA[2], voffB[2];
#pragma unroll
    for (int i = 0; i < 2; ++i) { int R, C; stage_rc(tid * 16 + i * 8192, R, C); const int Rb = Epi::PERM ? ((R & ~31) + perm32(R & 31)) : R;
        RA[i] = R; CA[i] = C; voffA[i] = (unsigned)(R * K + C) * 2u; voffB[i] = (unsigned)(Rb * K + C) * 2u; }
    const size_t kstep = (size_t)(BK * 2);
    const size_t hstep = (size_t)HALF * K * 2;
    const size_t tstep = 2 * hstep;
    const unsigned ldsw = (unsigned)wid * 1024u;
    const int aoff = lds_byte(wr * 64 + fr, fq * 8), boff = lds_byte(wc * 32 + fr, fq * 8);
#define PG8_SA(b, h) (((b) * 2 + (h)) * HTB)
#define PG8_SB(b, h) ((4 + (b) * 2 + (h)) * HTB)
#define PG8_STAGE(bufoff, gbase, voff) do { _Pragma("unroll") for (int _i = 0; _i < 2; ++_i) \
        __builtin_amdgcn_global_load_lds((const unsigned*)((const char*)(gbase) + (voff)[_i]), (LAS unsigned*)(lds + (bufoff) + ldsw + _i * 8192), 16, 0, 0); } while (0)
#define PG8_STAGE_A(bufoff, h, gptr, OO) do { if constexpr (GATHER) { PG8_STAGE(bufoff, gptr, (OO)[h]); } else { PG8_STAGE(bufoff, (gptr) + ((h) ? hstep : 0), voffA); } } while (0)
#define PG8_MKOFF(u, o) do { if constexpr (GATHER) { _Pragma("unroll") for (int _h = 0; _h < 2; ++_h) _Pragma("unroll") for (int _i = 0; _i < 2; ++_i) { \
        const int _row = g.rowmap[(u).pm * BM + _h * HALF + RA[_i]]; (o)[_h][_i] = ((unsigned)_row * (unsigned)K + (unsigned)CA[_i]) * 2u; } } } while (0)
#define PG8_LDA(dst, b, h) do { _Pragma("unroll") for (int m = 0; m < 4; ++m) _Pragma("unroll") for (int k = 0; k < 2; ++k) dst[m][k] = *(const LAS bf16x8*)(lds + PG8_SA(b, h) + aoff + m * 2048 + k * 1024); } while (0)
#define PG8_LDB(dst, b, h) do { _Pragma("unroll") for (int n = 0; n < 2; ++n) _Pragma("unroll") for (int k = 0; k < 2; ++k) dst[n][k] = *(const LAS bf16x8*)(lds + PG8_SB(b, h) + boff + n * 2048 + k * 1024); } while (0)
#define PG8_MMA(ai, bj, At, Bt) do { __builtin_amdgcn_s_setprio(1); _Pragma("unroll") for (int m = 0; m < 4; ++m) _Pragma("unroll") for (int n = 0; n < 2; ++n) _Pragma("unroll") for (int k = 0; k < 2; ++k) \
        acc[ai][bj][m][n] = __builtin_amdgcn_mfma_f32_16x16x32_bf16(Bt[n][k], At[m][k], acc[ai][bj][m][n], 0, 0, 0); __builtin_amdgcn_s_setprio(0); } while (0)
#define PG8_WAIT_V(n) asm volatile("s_waitcnt vmcnt(" #n ")" ::: "memory")
#define PG8_WAIT_L(n) asm volatile("s_waitcnt lgkmcnt(" #n ")" ::: "memory")
#define PG8_BAR __builtin_amdgcn_s_barrier()
#define PG8_SCHED __builtin_amdgcn_sched_barrier(0)
    Unit cur, nxt; int ui = 0;
    if (!S.next(0, cur)) return;
    f32x4 acc[2][2][4][2];
#pragma unroll
    for (int a = 0; a < 2; ++a)
#pragma unroll
        for (int b = 0; b < 2; ++b)
#pragma unroll
            for (int m = 0; m < 4; ++m)
#pragma unroll
                for (int n = 0; n < 2; ++n) acc[a][b][m][n] = (f32x4){0.f, 0.f, 0.f, 0.f};
    bf16x8 At[4][2], B0[2][2], B1[2][2];
    unsigned cO[2][2] = {{0u, 0u}, {0u, 0u}}, nO[2][2] = {{0u, 0u}, {0u, 0u}};
    PG8_MKOFF(cur, cO);
    const char* cA = (const char*)g.A + (GATHER ? (size_t)0 : (size_t)cur.pm * tstep);
    const char* cB = (const char*)g.Bt + ((size_t)cur.e * g.N + (size_t)cur.pn * BM) * K * 2;
    PG8_STAGE(PG8_SB(0, 0), cB, voffB); PG8_STAGE(PG8_SB(0, 1), cB + hstep, voffB); PG8_STAGE_A(PG8_SA(0, 0), 0, cA, cO); PG8_STAGE_A(PG8_SA(0, 1), 1, cA, cO);
    if (wr == 1) PG8_BAR;
    PG8_WAIT_V(2); PG8_BAR;
    PG8_STAGE(PG8_SB(1, 0), cB + kstep, voffB); PG8_STAGE_A(PG8_SA(1, 0), 0, cA + kstep, cO); PG8_STAGE(PG8_SB(1, 1), cB + hstep + kstep, voffB);
    PG8_WAIT_V(6); PG8_BAR;
    for (;;) {
        const bool has_next = S.next(ui + 1, nxt);
        if (has_next) { PG8_MKOFF(nxt, nO); } else {
#pragma unroll
            for (int h = 0; h < 2; ++h)
#pragma unroll
                for (int i = 0; i < 2; ++i) nO[h][i] = cO[h][i]; }
        const char* nA = (has_next && !GATHER) ? (const char*)g.A + (size_t)nxt.pm * tstep : cA;
        const char* nB = has_next ? (const char*)g.Bt + ((size_t)nxt.e * g.N + (size_t)nxt.pn * BM) * K * 2 : cB;
        for (int t = 0; t < nt; t += 2) {
            const bool last = (t == nt - 2);
            const char* a1 = cA + (size_t)(t + 1) * kstep;
            const char* a2 = last ? nA : cA + (size_t)(t + 2) * kstep; const char* b2 = last ? nB : cB + (size_t)(t + 2) * kstep;
            const char* a3 = a2 + kstep; const char* b3 = b2 + kstep;
            unsigned o2[2][2];
#pragma unroll
            for (int h = 0; h < 2; ++h)
#pragma unroll
                for (int i = 0; i < 2; ++i) o2[h][i] = last ? nO[h][i] : cO[h][i];
            PG8_LDB(B0, 0, 0); PG8_LDB(B1, 0, 1); PG8_SCHED; PG8_LDA(At, 0, 0); PG8_STAGE_A(PG8_SA(1, 1), 1, a1, cO);
            PG8_WAIT_V(8); PG8_WAIT_L(0); PG8_BAR; PG8_MMA(0, 0, At, B0); PG8_MMA(0, 1, At, B1); PG8_BAR; PG8_SCHED;
            PG8_LDA(At, 0, 1); PG8_STAGE(PG8_SB(0, 0), b2, voffB); PG8_STAGE(PG8_SB(0, 1), b2 + hstep, voffB); PG8_STAGE_A(PG8_SA(0, 0), 0, a2, o2);
            PG8_WAIT_V(8); PG8_WAIT_L(0); PG8_BAR; PG8_MMA(1, 0, At, B0); PG8_MMA(1, 1, At, B1); PG8_BAR; PG8_SCHED;
            PG8_LDB(B0, 1, 0); PG8_LDB(B1, 1, 1); PG8_SCHED; PG8_LDA(At, 1, 0); PG8_STAGE_A(PG8_SA(0, 1), 1, a2, o2);
            PG8_WAIT_V(8); PG8_WAIT_L(0); PG8_BAR; PG8_MMA(0, 0, At, B0); PG8_MMA(0, 1, At, B1); PG8_BAR; PG8_SCHED;
            PG8_LDA(At, 1, 1); PG8_STAGE(PG8_SB(1, 0), b3, voffB); PG8_STAGE(PG8_SB(1, 1), b3 + hstep, voffB); PG8_STAGE_A(PG8_SA(1, 0), 0, a3, o2);
            PG8_WAIT_V(8); PG8_WAIT_L(0); PG8_BAR; PG8_MMA(1, 0, At, B0); PG8_MMA(1, 1, At, B1); PG8_BAR; PG8_SCHED;
        }
        if constexpr (ALIGN_EPI) { if (wr == 0) PG8_BAR; }
        E(acc, cur, wr, wc, fr, fq);
        if (!has_next) break;
#pragma unroll
        for (int a = 0; a < 2; ++a)
#pragma unroll
            for (int b = 0; b < 2; ++b)
#pragma unroll
                for (int m = 0; m < 4; ++m)
#pragma unroll
                    for (int n = 0; n < 2; ++n) acc[a][b][m][n] = (f32x4){0.f, 0.f, 0.f, 0.f};
        cur = nxt; cA = nA; cB = nB; ++ui;
#pragma unroll
        for (int h = 0; h < 2; ++h)
#pragma unroll
            for (int i = 0; i < 2; ++i) cO[h][i] = nO[h][i];
        if constexpr (ALIGN_EPI) { if (wr == 1) PG8_BAR; }
    }
    PG8_WAIT_V(0);
    if constexpr (!ALIGN_EPI) { if (wr == 0) PG8_BAR; }
    PG8_BAR;
#undef PG8_SA
#undef PG8_SB
#undef PG8_STAGE
#undef PG8_STAGE_A
#undef PG8_MKOFF
#undef PG8_LDA
#undef PG8_LDB
#undef PG8_MMA
#undef PG8_WAIT_V
#undef PG8_WAIT_L
#undef PG8_BAR
#undef PG8_SCHED
}
}

namespace att {
__device__ __forceinline__ int crow(int r, int hi) { return (r & 3) + 8 * (r >> 2) + 4 * hi; }
__device__ __forceinline__ int v_st(int k, int c) { const int kk = (k & ~0xC) | ((k & 4) << 1) | ((k & 8) >> 1); return ((kk >> 3) * 4 + (c >> 5)) * 512 + ((kk & 7) * 32 + (c & 31)) * 2; }
__device__ __forceinline__ int v_rd_base(int lane) { return ((lane & 3) << 3) | (((lane >> 2) & 3) << 6) | (((lane >> 4) & 1) << 5) | (((lane >> 5) & 1) << 8); }
constexpr int v_rd_off(int d0, int ks, int half) { return d0 * 512 + ks * 4096 + half * 2048; }
template <int OFF> __device__ __forceinline__ s16x4 tr_read(int vb) {
    s16x4 r; asm volatile("ds_read_b64_tr_b16 %0, %1 offset:%2" : "=&v"(r) : "v"(vb), "i"(OFF) : "memory"); return r;
}
template <int D0> __device__ __forceinline__ void pv_one(f32x16& od, int vb, bf16x8 pa0, bf16x8 pa1, bf16x8 pa2, bf16x8 pa3) {
    const s16x4 l0 = tr_read<v_rd_off(D0, 0, 0)>(vb), h0 = tr_read<v_rd_off(D0, 0, 1)>(vb), l1 = tr_read<v_rd_off(D0, 1, 0)>(vb), h1 = tr_read<v_rd_off(D0, 1, 1)>(vb);
    const s16x4 l2 = tr_read<v_rd_off(D0, 2, 0)>(vb), h2 = tr_read<v_rd_off(D0, 2, 1)>(vb), l3 = tr_read<v_rd_off(D0, 3, 0)>(vb), h3 = tr_read<v_rd_off(D0, 3, 1)>(vb);
    asm volatile("s_waitcnt lgkmcnt(0)" ::: "memory"); __builtin_amdgcn_sched_barrier(0);
#define ATT_PK(L, H) (bf16x8){L[0], L[1], L[2], L[3], H[0], H[1], H[2], H[3]}
    od = __builtin_amdgcn_mfma_f32_32x32x16_bf16(pa0, ATT_PK(l0, h0), od, 0, 0, 0);
    od = __builtin_amdgcn_mfma_f32_32x32x16_bf16(pa1, ATT_PK(l1, h1), od, 0, 0, 0);
    od = __builtin_amdgcn_mfma_f32_32x32x16_bf16(pa2, ATT_PK(l2, h2), od, 0, 0, 0);
    od = __builtin_amdgcn_mfma_f32_32x32x16_bf16(pa3, ATT_PK(l3, h3), od, 0, 0, 0);
#undef ATT_PK
}
template <int DK> __device__ __forceinline__ void qkt(f32x16& p0, f32x16& p1, const LAS char* Ks, const bf16x8* qr, int r32, int hi) {
    p0 = (f32x16){0, 0, 0, 0, 0, 0, 0, 0, 0, 0, 0, 0, 0, 0, 0, 0}; p1 = p0;
#pragma unroll
    for (int d0 = 0; d0 < DK / 16; ++d0) { const int cb = (d0 * 16 + hi * 8) * 2;
        const bf16x8 b0 = *(const LAS bf16x8*)(Ks + r32 * (2 * DK) + (cb ^ ((r32 & 7) << 4)));
        const bf16x8 b1 = *(const LAS bf16x8*)(Ks + (32 + r32) * (2 * DK) + (cb ^ ((r32 & 7) << 4)));
        p0 = __builtin_amdgcn_mfma_f32_32x32x16_bf16(b0, qr[d0], p0, 0, 0, 0);
        p1 = __builtin_amdgcn_mfma_f32_32x32x16_bf16(b1, qr[d0], p1, 0, 0, 0); }
}
struct Cfg {
    int qrow0;
    int qcol, kcol, vcol;
    int ctxrow0;
    int latrow0;
    int lat0, nlat;
    int mode;
    int qb;
    int ocol;
    float sink2;
    const float* rpb;
};
constexpr int L_V = 0, L_K = 32768, L_WS = 65536, L_BIAS = 65536 + 2048 + 1024;

template <int DK, bool OUTF32>
__device__ __forceinline__ void attn_unit(LAS unsigned char* lds, const bf16_t* __restrict__ P, bf16_t* __restrict__ Obf, float* __restrict__ Of32, int ldo, const Cfg& c, int tid, int wid, int lane) {
    constexpr int ND = DK / 16;
    const int r32 = lane & 31, hi = lane >> 5;
    const LAS char* Vl = (const LAS char*)(lds + L_V); const LAS char* Kl = (const LAS char*)(lds + L_K);
    LAS float* wsf = (LAS float*)(lds + L_WS) + wid * 64; LAS float* biasl = (LAS float*)(lds + L_BIAS);
    const float C2 = (DK == 128 ? 0.08838834764831845f : 0.125f) * LOG2E;
    bf16x8 qr[ND];
    { const bf16_t* Pq = P + (size_t)(c.qrow0 + wid * 32 + r32) * INW + c.qcol + hi * 8;
#pragma unroll
      for (int d0 = 0; d0 < ND; ++d0) qr[d0] = *(const bf16x8*)(Pq + d0 * 16); }
    if (c.mode == 1) for (int i = tid; i < 465; i += 512) biasl[i] = c.rpb[i] * LOG2E;
    const int vsr = tid >> 4, vsc = (tid & 15) * 8;
    const int ksr = (DK == 128) ? (tid >> 4) : (tid >> 3), ksc = (DK == 128) ? (tid & 15) * 8 : (tid & 7) * 8;
    const int vst0 = v_st(vsr, vsc), vst1 = v_st(32 + vsr, vsc);
    const int kst0 = ksr * (2 * DK) + ((ksc * 2) ^ ((ksr & 7) << 4)), kst1 = (32 + ksr) * (2 * DK) + ((ksc * 2) ^ ((ksr & 7) << 4));
    const int vb0 = (int)(unsigned)(size_t)(lds + L_V) + v_rd_base(lane);
    const int NT = 4 + c.nlat;
    bf16x8 vs0, vs1, ks0, ks1;
#define ATT_SLOAD(j) do { const int _kr = ((j) < 4) ? (c.ctxrow0 + 64 * (j)) : (c.latrow0 + 64 * (c.lat0 + (j) - 4)); \
        const bf16_t* _v = P + (size_t)(_kr + vsr) * INW + c.vcol + vsc; vs0 = *(const bf16x8*)_v; vs1 = *(const bf16x8*)(_v + (size_t)32 * INW); \
        const bf16_t* _k = P + (size_t)(_kr + ksr) * INW + c.kcol + ksc; ks0 = *(const bf16x8*)_k; if (DK == 128) ks1 = *(const bf16x8*)(_k + (size_t)32 * INW); } while (0)
#define ATT_SWRITE(b) do { *(LAS bf16x8*)(lds + L_V + (b) * 16384 + vst0) = vs0; *(LAS bf16x8*)(lds + L_V + (b) * 16384 + vst1) = vs1; \
        *(LAS bf16x8*)(lds + L_K + (b) * 16384 + kst0) = ks0; if (DK == 128) *(LAS bf16x8*)(lds + L_K + (b) * 16384 + kst1) = ks1; } while (0)
    float m_reg = -1e30f, l_reg = 0.f;
    f32x16 o[4];
#pragma unroll
    for (int d = 0; d < 4; ++d) o[d] = (f32x16){0, 0, 0, 0, 0, 0, 0, 0, 0, 0, 0, 0, 0, 0, 0, 0};
    ATT_SLOAD(0); ATT_SWRITE(0); __syncthreads();
    const int q0w = 256 * c.qb + 32 * wid;
    const int qrw = 4 * c.qb + (wid >> 1);
    const int r0w = qrw - 4 < 0 ? 0 : (qrw - 4 > 56 ? 56 : qrw - 4);
    for (int j = 0; j < NT; ++j) {
        const int buf = j & 1;
        if (j + 1 < NT) ATT_SLOAD(j + 1);
        int tmode = 0; bool skip = false; const int lt = c.lat0 + j - 4;
        if (j >= 4) {
            if (c.mode == 1) { tmode = 1; skip = (lt < r0w) || (lt >= r0w + 8); }
            else if (c.mode == 2) { const int k0 = 64 * lt; skip = (k0 > q0w + 31 + 128) || (k0 + 63 < q0w - 128); tmode = ((k0 >= q0w + 31 - 128) && (k0 + 63 <= q0w + 128)) ? 0 : 2; }
        }
        if (!skip) {
            f32x16 p0, p1;
            qkt<DK>(p0, p1, Kl + buf * 16384, qr, r32, hi);
            if (tmode == 0) {
#pragma unroll
                for (int r = 0; r < 16; ++r) { p0[r] *= C2; p1[r] *= C2; }
            } else if (tmode == 1) {
                const int qc = 32 * (wid & 1) + r32;
                const int c0 = qc - 8 < 0 ? 0 : (qc - 8 > 48 ? 48 : qc - 8);
                int z = c0 - 4 * hi; asm volatile("" : "+v"(z));
                const int bbase = (lt - qrw + 7) * 31 + 15 - qc + 4 * hi;
#pragma unroll
                for (int r = 0; r < 16; ++r) { const int kcl = (r & 3) + 8 * (r >> 2);
                    const float b0 = biasl[bbase + kcl], b1 = biasl[bbase + kcl + 32];
                    p0[r] = ((unsigned)(kcl - z) < 16u) ? (p0[r] * C2 + b0) : -1e30f;
                    p1[r] = ((unsigned)(kcl + 32 - z) < 16u) ? (p1[r] * C2 + b1) : -1e30f; }
            } else {
                const int dq = q0w + r32 - 64 * lt - 4 * hi;
#pragma unroll
                for (int r = 0; r < 16; ++r) { const int kcl = (r & 3) + 8 * (r >> 2);
                    const int d0 = dq - kcl, d1 = d0 - 32;
                    p0[r] = ((unsigned)(d0 + 128) <= 256u) ? p0[r] * C2 : -1e30f;
                    p1[r] = ((unsigned)(d1 + 128) <= 256u) ? p1[r] * C2 : -1e30f; }
            }
            float pmax = p0[0];
#pragma unroll
            for (int r = 1; r < 16; ++r) pmax = fmaxf(pmax, p0[r]);
#pragma unroll
            for (int r = 0; r < 16; ++r) pmax = fmaxf(pmax, p1[r]);
            { auto rr = __builtin_amdgcn_permlane32_swap(__float_as_uint(pmax), __float_as_uint(pmax), false, false);
              pmax = fmaxf(__uint_as_float(rr[0]), __uint_as_float(rr[1])); }
            const float mn = fmaxf(m_reg, pmax), alpha = __builtin_amdgcn_exp2f(m_reg - mn);
            m_reg = mn;
            float ps = 0.f;
#pragma unroll
            for (int r = 0; r < 16; ++r) { p0[r] = __builtin_amdgcn_exp2f(p0[r] - mn); p1[r] = __builtin_amdgcn_exp2f(p1[r] - mn); ps += p0[r] + p1[r]; }
            { auto rr = __builtin_amdgcn_permlane32_swap(__float_as_uint(ps), __float_as_uint(ps), false, false);
              ps = __uint_as_float(rr[0]) + __uint_as_float(rr[1]); }
            l_reg = l_reg * alpha + ps;
            bf16x8 pa0, pa1, pa2, pa3;
#define ATT_PK4(Pv, BASE, OUT) do { unsigned a0 = cvt_pk_bf16(Pv[BASE + 0], Pv[BASE + 1]), a1 = cvt_pk_bf16(Pv[BASE + 2], Pv[BASE + 3]); \
    unsigned b0 = cvt_pk_bf16(Pv[BASE + 4], Pv[BASE + 5]), b1 = cvt_pk_bf16(Pv[BASE + 6], Pv[BASE + 7]); \
    auto r0 = __builtin_amdgcn_permlane32_swap(a0, b0, false, false); auto r1 = __builtin_amdgcn_permlane32_swap(a1, b1, false, false); \
    u32x4 w = {r0[0], r1[0], r0[1], r1[1]}; OUT = __builtin_bit_cast(bf16x8, w); } while (0)
            ATT_PK4(p0, 0, pa0); ATT_PK4(p0, 8, pa1); ATT_PK4(p1, 0, pa2); ATT_PK4(p1, 8, pa3);
#undef ATT_PK4
            if (__any(alpha < 1.f)) {
                if (hi == 0) wsf[r32] = alpha;
                LDS_WAIT();
#pragma unroll
                for (int r = 0; r < 16; ++r) { const float a = wsf[crow(r, hi)];
#pragma unroll
                    for (int d = 0; d < 4; ++d) o[d][r] *= a; }
                LDS_WAIT();
            }
            const int vb = vb0 + buf * 16384;
            pv_one<0>(o[0], vb, pa0, pa1, pa2, pa3); pv_one<1>(o[1], vb, pa0, pa1, pa2, pa3); pv_one<2>(o[2], vb, pa0, pa1, pa2, pa3); pv_one<3>(o[3], vb, pa0, pa1, pa2, pa3);
        }
        if (j + 1 < NT) ATT_SWRITE(buf ^ 1);
        __syncthreads();
    }
#undef ATT_SLOAD
#undef ATT_SWRITE
    if (c.sink2 > -1e29f) l_reg += __builtin_amdgcn_exp2f(c.sink2 - m_reg);
    if (hi == 0) wsf[32 + r32] = l_reg;
    LDS_WAIT();
    float rli[16];
#pragma unroll
    for (int r = 0; r < 16; ++r) rli[r] = 1.0f / wsf[32 + crow(r, hi)];
    LDS_WAIT();
    const int orow0 = c.qrow0 + wid * 32;
    if constexpr (OUTF32) {
#pragma unroll
        for (int r = 0; r < 16; ++r) { float* op = Of32 + (size_t)(orow0 + crow(r, hi)) * ldo + c.ocol + r32;
#pragma unroll
            for (int d0 = 0; d0 < 4; ++d0) op[d0 * 32] = o[d0][r] * rli[r]; }
    } else {
        const bool odd = (r32 & 1) != 0;
#pragma unroll
        for (int r = 0; r < 16; r += 2) {
            bf16_t* op = Obf + (size_t)(orow0 + crow(r, hi) + (odd ? 1 : 0)) * ldo + c.ocol + (r32 & ~1);
#pragma unroll
            for (int d0 = 0; d0 < 4; ++d0) { const float va = o[d0][r] * rli[r], vb2 = o[d0][r + 1] * rli[r + 1];
                const float snd = odd ? va : vb2; const float rcv = lane_xor<1>(snd);
                const unsigned w = odd ? cvt_pk_bf16(rcv, vb2) : cvt_pk_bf16(va, rcv);
                *(unsigned*)(op + d0 * 32) = w; }
        }
    }
}
}

#define XB_TMO      128
#define XB_XCNT(j)  (256  + 64 * (j))
#define XB_XSUB(j)  (1280 + 64 * (j))
#define XB_XGEN(j)  (2304 + 64 * (j))
#define XB_TOP      3328
#define XB_TOPGEN   3392
#define XCD_BAR_WORDS 3456
#define XB_SPIN_CAP (1u << 22)
__device__ __forceinline__ unsigned xb_ld(unsigned* p)              { return __hip_atomic_load(p, __ATOMIC_RELAXED, __HIP_MEMORY_SCOPE_AGENT); }
__device__ __forceinline__ unsigned xb_add(unsigned* p, unsigned v) { return __hip_atomic_fetch_add(p, v, __ATOMIC_RELAXED, __HIP_MEMORY_SCOPE_AGENT); }
__device__ __forceinline__ unsigned xb_xcc_id() { return (unsigned)__builtin_amdgcn_s_getreg((3 << 11) | 20) & 0xFu; }
#define XB_SPIN(cond, bar) do { unsigned _sp = 0; while (cond) { __builtin_amdgcn_s_sleep(1); \
    if ((++_sp & 255u) == 0u) { if (xb_ld(&(bar)[XB_TMO])) break; if (_sp > XB_SPIN_CAP) { atomicAdd(&(bar)[XB_TMO], 1u); break; } } } } while (0)
struct XcdBarrier { unsigned* bar; unsigned x; volatile LAS unsigned* st; };
__device__ __forceinline__ XcdBarrier xcd_barrier_post(unsigned* bar, volatile LAS unsigned* st) {
    XcdBarrier b; b.bar = bar; b.x = xb_xcc_id(); b.st = st;
    if (threadIdx.x == 0) (void)xb_add(&bar[XB_XCNT(b.x)], 1u);
    return b;
}
__device__ __forceinline__ void xcd_barrier_complete(unsigned* bar, unsigned x, unsigned& nloc, unsigned& nx) {
    const unsigned G = gridDim.x * gridDim.y * gridDim.z;
    unsigned sum, cnt, mine, sp = 0u;
    for (;;) {
        sum = 0u; cnt = 0u; mine = 0u;
#pragma unroll
        for (unsigned j = 0; j < 16; ++j) { const unsigned c = xb_ld(&bar[XB_XCNT(j)]); sum += c; cnt += (c > 0u) ? 1u : 0u; mine = (j == x) ? c : mine; }
        if (sum == G) break;
        __builtin_amdgcn_s_sleep(1);
        if ((++sp & 255u) == 0u) { if (xb_ld(&bar[XB_TMO])) break; if (sp > XB_SPIN_CAP) { atomicAdd(&bar[XB_TMO], 1u); break; } }
    }
    nloc = mine > 0u ? mine : 1u; nx = cnt > 0u ? cnt : 1u;
}
__device__ __forceinline__ void xcd_barrier(const XcdBarrier& b) {
    asm volatile("s_waitcnt vmcnt(0)" ::: "memory");
    __syncthreads();
    if (threadIdx.x == 0) {
        unsigned* bar = b.bar;
        __builtin_amdgcn_s_waitcnt(0);
        unsigned nloc = b.st[0], nx = b.st[1];
        if (nloc == 0u) { xcd_barrier_complete(bar, b.x, nloc, nx); b.st[0] = nloc; b.st[1] = nx; }
        const unsigned old = xb_add(&bar[XB_XSUB(b.x)], 1u);
        const unsigned gen = old / nloc;
        if (old + 1u == (gen + 1u) * nloc) {
            __builtin_amdgcn_fence(__ATOMIC_RELEASE, "agent");
            asm volatile("s_waitcnt vmcnt(0)" ::: "memory");
            const unsigned og = xb_add(&bar[XB_TOP], 1u);
            const unsigned tg = og / nx;
            if (og + 1u == (tg + 1u) * nx) xb_add(&bar[XB_TOPGEN], 1u);
            else XB_SPIN(xb_ld(&bar[XB_TOPGEN]) == tg, bar);
            __builtin_amdgcn_fence(__ATOMIC_ACQUIRE, "agent");
            xb_add(&bar[XB_XGEN(b.x)], 1u);
            asm volatile("s_waitcnt vmcnt(0)" ::: "memory");
        } else {
            XB_SPIN(xb_ld(&bar[XB_XGEN(b.x)]) == gen, bar);
            __builtin_amdgcn_fence(__ATOMIC_ACQUIRE, "agent");
            asm volatile("s_waitcnt vmcnt(0)" ::: "memory");
        }
    }
    __syncthreads();
}

struct Args {
    const float *x, *c, *ctx, *c_ctx, *ada_w, *ada_b, *norm1_g, *norm2_g, *w_in, *w_out, *na_q_norm, *na_k_norm, *na_rpb, *sw_q_norm, *sw_k_norm, *sw_sink,
                *df_q_norm, *df_k_norm, *df_lambda, *df_subln_g, *ffn_w1, *ffn_w3, *ffn_w2, *moe_router, *moe_w1, *moe_w3, *moe_w2;
    float* out; unsigned char* ws; int ph_lo, ph_hi;
};

__device__ __forceinline__ void tr_item(const float* __restrict__ W, int K, int N, bf16_t* __restrict__ WT, int mode, int item, int lane) {
    const int nblk = N >> 6, kb = item / nblk, nb = item - kb * nblk, k0 = kb * 32, n = nb * 64 + lane;
    const float* src = W + (size_t)k0 * N + n;
    float v[32];
#pragma unroll
    for (int i = 0; i < 32; ++i) v[i] = src[(size_t)i * N];
    int orow = n; if (mode) orow = ((n >> 4) << 5) + (n & 15) + (mode == 2 ? 16 : 0);
    u32x4* dst = (u32x4*)(WT + (size_t)orow * K + k0);
#pragma unroll
    for (int q = 0; q < 4; ++q) { u32x4 w; w.x = cvt_pk_bf16(v[8 * q], v[8 * q + 1]); w.y = cvt_pk_bf16(v[8 * q + 2], v[8 * q + 3]); w.z = cvt_pk_bf16(v[8 * q + 4], v[8 * q + 5]); w.w = cvt_pk_bf16(v[8 * q + 6], v[8 * q + 7]); dst[q] = w; }
}

typedef const __attribute__((address_space(4))) Args KArgs;
__device__ __forceinline__ KArgs* kargs() { KArgs* p = (KArgs*)__builtin_amdgcn_kernarg_segment_ptr(); asm volatile("" : "+s"(p)); return p; }
#define PH_BEGIN KArgs* A = kargs(); unsigned char* const ws = A->ws; unsigned* const ctl = (unsigned*)(ws + WS_CTL); (void)ctl; \
    int tid = threadIdx.x; asm volatile("" : "+v"(tid)); const int lane = tid & 63, wave = __builtin_amdgcn_readfirstlane(tid >> 6); const int gw = vcu * 8 + wave; (void)lane; (void)gw;

__global__ void __launch_bounds__(512, 2) mk_fwd(Args A_unused) {
    extern __shared__ __attribute__((aligned(16))) unsigned char lds_raw[];
    LAS unsigned char* lds = (LAS unsigned char*)lds_raw;
    volatile LAS unsigned* MISC = (volatile LAS unsigned*)(lds + MISC_OFF);
    const int G = gridDim.x; const int bx = blockIdx.x; const int vcu = (G % 8 == 0) ? (bx % 8) * (G / 8) + bx / 8 : bx;
    const int NGW = G * 8;
    for (int u = threadIdx.x; u < (LDS_BYTES - LDSCTL_OFF) / 4; u += 512) ((LAS unsigned*)(lds + LDSCTL_OFF))[u] = 0u;
    __syncthreads();
    XcdBarrier bar; bar.bar = nullptr; bar.x = 0; bar.st = nullptr;
    int lo, hi;
    { KArgs* A = kargs(); lo = A->ph_lo; hi = A->ph_hi; unsigned* ctl0 = (unsigned*)(A->ws + WS_CTL); bar.bar = ctl0 + CW_BAR;
      if (!MK_PER_PHASE) bar = xcd_barrier_post(ctl0 + CW_BAR, MISC + 8); }
#ifndef EN_MASK
#define EN_MASK 0xFFFFFFFFu
#endif
#define IN(k) (lo <= (k) && (k) < hi)
#define EN(b) ((EN_MASK >> (b)) & 1u)
#define SEAM(k) do { if (!MK_PER_PHASE) { if (IN(k) && IN((k) + 1)) xcd_barrier(bar); } } while (0)
#define WSP(T, off) ((T*)(ws + (off)))

    if (EN(0) && IN(0)) { PH_BEGIN
        LAS float* sv = (LAS float*)lds;
        LAS float* part = (LAS float*)(lds + 40960);
        for (int i = tid; i < 5 * D; i += 512) { const int v = i >> 11, k = i & (D - 1); const float xv = (v < 4) ? A->c[v * D + k] : A->c_ctx[k]; sv[i] = xv / (1.0f + __expf(-xv)); }
        __syncthreads();
        for (int it = vcu; it < 768; it += G) {
            const int L = it / 384, col0 = (it % 384) * 32, colx = col0 + (lane & 31), ks = lane >> 5;
            const float* wp = A->ada_w + (size_t)L * D * 12288 + colx;
            float acc[5] = {0.f, 0.f, 0.f, 0.f, 0.f};
            for (int kk = 0; kk < 256; kk += 16) {
                float a[8];
#pragma unroll
                for (int q = 0; q < 8; ++q) a[q] = wp[(size_t)(256 * wave + kk + 2 * q + ks) * 12288];
#pragma unroll
                for (int q = 0; q < 8; ++q) { const int k = 256 * wave + kk + 2 * q + ks;
#pragma unroll
                    for (int v = 0; v < 5; ++v) acc[v] += sv[v * D + k] * a[q]; }
            }
#pragma unroll
            for (int v = 0; v < 5; ++v) { { auto rr = __builtin_amdgcn_permlane32_swap(__float_as_uint(acc[v]), __float_as_uint(acc[v]), false, false); acc[v] = __uint_as_float(rr[0]) + __uint_as_float(rr[1]); } if (lane < 32) part[(wave * 5 + v) * 32 + lane] = acc[v]; }
            __syncthreads();
            if (tid < 160) { const int v = tid >> 5, cc = tid & 31; float s = 0.f;
#pragma unroll
                for (int w = 0; w < 8; ++w) s += part[(w * 5 + v) * 32 + cc];
                WSP(float, WS_MOD)[(size_t)(L * 5 + v) * 12288 + col0 + cc] = s + A->ada_b[L * 12288 + col0 + cc]; }
            __syncthreads();
        }
        constexpr int I_IN = 5120, I_OUT = 2048, I_FF = 5632;
        constexpr int NIT = 2 * I_IN + 2 * I_OUT + 3 * I_FF + 24 * I_FF;
        for (int it = gw; it < NIT; it += NGW) {
            int r = it;
            if (r < 2 * I_IN) { const int L = r / I_IN; tr_item(A->w_in + (size_t)L * D * INW, D, INW, WSP(bf16_t, WS_WIN) + (size_t)L * INW * D, 0, r % I_IN, lane); continue; } r -= 2 * I_IN;
            if (r < 2 * I_OUT) { const int L = r / I_OUT; tr_item(A->w_out + (size_t)L * D * D, D, D, WSP(bf16_t, WS_WOUT) + (size_t)L * D * D, 0, r % I_OUT, lane); continue; } r -= 2 * I_OUT;
            if (r < I_FF) { tr_item(A->ffn_w1, D, FF, WSP(bf16_t, WS_W13), 1, r, lane); continue; } r -= I_FF;
            if (r < I_FF) { tr_item(A->ffn_w3, D, FF, WSP(bf16_t, WS_W13), 2, r, lane); continue; } r -= I_FF;
            if (r < I_FF) { tr_item(A->ffn_w2, FF, D, WSP(bf16_t, WS_W2), 0, r, lane); continue; } r -= I_FF;
            const int j = r / I_FF, ty = j >> 3, e = j & 7, rr = r % I_FF;
            if (ty == 0) tr_item(A->moe_w1 + (size_t)e * D * FF, D, FF, WSP(bf16_t, WS_MW13) + (size_t)e * FF2 * D, 1, rr, lane);
            else if (ty == 1) tr_item(A->moe_w3 + (size_t)e * D * FF, D, FF, WSP(bf16_t, WS_MW13) + (size_t)e * FF2 * D, 2, rr, lane);
            else tr_item(A->moe_w2 + (size_t)e * FF * D, FF, D, WSP(bf16_t, WS_MW2) + (size_t)e * D * FF, 0, rr, lane);
        }
    }
    SEAM(0);

#pragma unroll 1
    for (int L = 0; L < 2; ++L) {
        const int pb = 1 + 16 * L;
#define modL (WSP(float, WS_MOD) + (size_t)L * 5 * 12288)
        const int MROWS = (L == 0) ? R_ALL : LAT;
        if (EN(1) && IN(pb + 0)) { PH_BEGIN
            const float* gain = A->norm1_g + L * D;
            for (int m = gw; m < R_ALL; m += NGW) {
                const bool isctx = m >= LAT; const int b = isctx ? 4 : (m >> 12);
                const float* xr = (L == 0) ? (isctx ? A->ctx + (size_t)(m - LAT) * D : A->x + (size_t)m * D) : (isctx ? WSP(float, WS_XC) + (size_t)(m - LAT) * D : A->out + (size_t)m * D);
                const float* sh = modL + (size_t)b * 12288; const float* sc = sh + D;
                f32x4 v[8]; float ss = 0.f;
#pragma unroll
                for (int j = 0; j < 8; ++j) { v[j] = *(const f32x4*)(xr + 256 * j + 4 * lane); ss += (v[j].x * v[j].x + v[j].y * v[j].y) + (v[j].z * v[j].z + v[j].w * v[j].w); }
                const float rinv = rsqrtf(wave_sum(ss) * (1.0f / D) + NORM_EPS);
                bf16_t* orow = WSP(bf16_t, WS_H) + (size_t)m * D;
#pragma unroll
                for (int j = 0; j < 8; ++j) { const int cidx = 256 * j + 4 * lane; const f32x4 gq = *(const f32x4*)(gain + cidx), s4 = *(const f32x4*)(sc + cidx), h4 = *(const f32x4*)(sh + cidx);
                    const f32x4 y = v[j] * rinv * gq * (1.0f + s4) + h4; u32x2 w; w.x = cvt_pk_bf16(y.x, y.y); w.y = cvt_pk_bf16(y.z, y.w); *(u32x2*)(orow + cidx) = w; }
            }
        }
        SEAM(pb + 0);
        if (EN(2) && IN(pb + 1)) { PH_BEGIN
            pg8::Gemm g{WSP(bf16_t, WS_H), WSP(bf16_t, WS_WIN) + (size_t)L * INW * D, INW, D, nullptr}; pg8::StaticOrder S; S.init(R_ALL, INW, G, bx);
            pg8::EpiBf16 E{WSP(bf16_t, WS_P), INW};
            pg8::gemm_phase<pg8::EpiBf16, pg8::StaticOrder, false>(lds, g, S, E);
        }
        SEAM(pb + 1);
        if (EN(3) && IN(pb + 2)) { PH_BEGIN
            const int d1 = (lane & 31) + 64 * (lane >> 5), d2 = d1 + 32;
            const int li = lane & 31, e1 = (li & 15) + 32 * (li >> 4), e2 = e1 + 16;
            const float gaq1 = A->na_q_norm[L * 128 + d1], gaq2 = A->na_q_norm[L * 128 + d2], gak1 = A->na_k_norm[L * 128 + d1], gak2 = A->na_k_norm[L * 128 + d2];
            const float gbq1 = A->sw_q_norm[L * 128 + d1], gbq2 = A->sw_q_norm[L * 128 + d2], gbk1 = A->sw_k_norm[L * 128 + d1], gbk2 = A->sw_k_norm[L * 128 + d2];
            const float gcq1 = A->df_q_norm[L * 64 + e1], gcq2 = A->df_q_norm[L * 64 + e2], gck1 = A->df_k_norm[L * 64 + e1], gck2 = A->df_k_norm[L * 64 + e2];
            const float ifB = exp2f(-(float)(2 * (lane & 31)) * (1.0f / 64.0f) * 13.287712379549449f);
            const float ifC = exp2f(-(float)(2 * (li & 15)) * (1.0f / 32.0f) * 13.287712379549449f);
            for (int m = gw; m < R_ALL; m += NGW) {
                const bool rope = m < LAT; const int t = m & (SEQ - 1);
                float csB = 1.f, snB = 0.f, csC = 1.f, snC = 0.f;
                if (rope) { const float posB = (lane < 32) ? (float)(t >> 6) : (float)(t & 63); sincosf(posB * ifB, &snB, &csB);
                            const float posC = (li < 16) ? (float)(t >> 6) : (float)(t & 63); sincosf(posC * ifC, &snC, &csC); }
                bf16_t* prow = WSP(bf16_t, WS_P) + (size_t)m * INW;
#define NR128(colbase, g1, g2, ROPE) do { bf16_t* p_ = prow + (colbase); const float x1 = bf2f(p_[d1]), x2 = bf2f(p_[d2]); \
        const float rinv = rsqrtf(wave_sum(x1 * x1 + x2 * x2) * (1.0f / 128.0f) + NORM_EPS); const float y1 = x1 * rinv * (g1), y2 = x2 * rinv * (g2); \
        float o1 = y1, o2 = y2; if (ROPE) { o1 = y1 * csB - y2 * snB; o2 = y2 * csB + y1 * snB; } p_[d1] = f2bf(o1); p_[d2] = f2bf(o2); } while (0)
                for (int h = 0; h < 6; ++h) NR128(C_QA + h * 128, gaq1, gaq2, false);
                for (int h = 0; h < 6; ++h) NR128(C_KA + h * 128, gak1, gak2, false);
                for (int h = 0; h < 6; ++h) NR128(C_QB + h * 128, gbq1, gbq2, rope);
                for (int h = 0; h < 2; ++h) NR128(C_KB + h * 128, gbk1, gbk2, rope);
#undef NR128
#define NR64(colbase, g1, g2) do { bf16_t* p_ = prow + (colbase) + (lane >> 5) * 64; const float x1 = bf2f(p_[e1]), x2 = bf2f(p_[e2]); float s_ = x1 * x1 + x2 * x2; \
        s_ = half_sum32(s_); \
        const float rinv = rsqrtf(s_ * (1.0f / 64.0f) + NORM_EPS); const float y1 = x1 * rinv * (g1), y2 = x2 * rinv * (g2); \
        float o1 = y1, o2 = y2; if (rope) { o1 = y1 * csC - y2 * snC; o2 = y2 * csC + y1 * snC; } p_[e1] = f2bf(o1); p_[e2] = f2bf(o2); } while (0)
                for (int h = 0; h < 4; ++h) NR64(C_QC + h * 128, gcq1, gcq2);
                for (int h = 0; h < 4; ++h) NR64(C_KC + h * 128, gck1, gck2);
#undef NR64
            }
        }
        SEAM(pb + 2);
        if (EN(4) && IN(pb + 3)) { PH_BEGIN
            const int nC = 512 + (L == 0 ? 32 : 0), nAB = 768 + (L == 0 ? 48 : 0);
            for (;;) {
                __syncthreads();
                if (tid == 0) MISC[0] = atomicAdd(ctl + CW_Q + 64 * (L * 2 + 0), 1u);
                __syncthreads();
                const int idx = (int)MISC[0];
                if (idx >= nC) break;
                att::Cfg c; c.mode = 0; c.sink2 = -1e30f; c.rpb = nullptr; c.lat0 = 0;
                int b, vh;
                if (idx < 512) { b = idx >> 7; vh = (idx >> 4) & 7; c.qb = idx & 15; c.qrow0 = b * SEQ + 256 * c.qb; c.nlat = 64; }
                else { const int k = idx - 512; b = k >> 3; vh = k & 7; c.qb = 0; c.qrow0 = LAT + b * CTXL; c.nlat = 0; }
                c.qcol = C_QC + vh * 64; c.kcol = C_KC + vh * 64; c.vcol = C_VC + (vh >> 1) * 128; c.ctxrow0 = LAT + b * CTXL; c.latrow0 = b * SEQ; c.ocol = vh * 128;
                att::attn_unit<64, true>(lds, WSP(bf16_t, WS_P), nullptr, WSP(float, WS_OC), 1024, c, tid, wave, lane);
            }
            for (;;) {
                __syncthreads();
                if (tid == 0) MISC[0] = atomicAdd(ctl + CW_Q + 64 * (L * 2 + 1), 1u);
                __syncthreads();
                const int idx = (int)MISC[0];
                if (idx >= nAB) break;
                att::Cfg c; c.sink2 = -1e30f; c.rpb = nullptr;
                int b, h, ty;
                if (idx < 384) { ty = 0; const int gq = idx >> 4; b = gq / 6; h = gq % 6; c.qb = idx & 15; }
                else if (idx < 768) { const int k = idx - 384; ty = 1; const int gq = k >> 4; b = gq / 6; h = gq % 6; c.qb = k & 15; }
                else { const int k = idx - 768; ty = (k < 24) ? 2 : 3; const int kk = (k < 24) ? k : k - 24; b = kk / 6; h = kk % 6; c.qb = 0; }
                c.ctxrow0 = LAT + b * CTXL; c.latrow0 = b * SEQ;
                if (ty == 0) { c.qrow0 = b * SEQ + 256 * c.qb; c.qcol = C_QA + h * 128; c.kcol = C_KA + h * 128; c.vcol = C_VA + h * 128; c.ocol = h * 128; c.mode = 1;
                    const int ra = 4 * c.qb - 4, rb = 4 * c.qb - 1; c.lat0 = ra < 0 ? 0 : (ra > 56 ? 56 : ra); const int last = (rb < 0 ? 0 : (rb > 56 ? 56 : rb)) + 7; c.nlat = last - c.lat0 + 1;
                    c.rpb = A->na_rpb + (size_t)(L * 6 + h) * 465; }
                else if (ty == 1) { c.qrow0 = b * SEQ + 256 * c.qb; c.qcol = C_QB + h * 128; c.kcol = C_KB + (h / 3) * 128; c.vcol = C_VB + (h / 3) * 128; c.ocol = 768 + h * 128; c.mode = 2;
                    const int ja = 4 * c.qb - 2, jb = 4 * c.qb + 6; c.lat0 = ja < 0 ? 0 : ja; c.nlat = (jb > 64 ? 64 : jb) - c.lat0; c.sink2 = A->sw_sink[L * 6 + h] * LOG2E; }
                else if (ty == 2) { c.qrow0 = LAT + b * CTXL; c.qcol = C_QA + h * 128; c.kcol = C_KA + h * 128; c.vcol = C_VA + h * 128; c.ocol = h * 128; c.mode = 0; c.lat0 = 0; c.nlat = 0; }
                else { c.qrow0 = LAT + b * CTXL; c.qcol = C_QB + h * 128; c.kcol = C_KB + (h / 3) * 128; c.vcol = C_VB + (h / 3) * 128; c.ocol = 768 + h * 128; c.mode = 0; c.lat0 = 0; c.nlat = 0; c.sink2 = A->sw_sink[L * 6 + h] * LOG2E; }
                att::attn_unit<128, false>(lds, WSP(bf16_t, WS_P), WSP(bf16_t, WS_O), nullptr, D, c, tid, wave, lane);
            }
        }
        SEAM(pb + 3);
        if (EN(5) && IN(pb + 4)) { PH_BEGIN
            const float* dl = A->df_lambda + L * 256;
            const float s1 = wave_sum(dl[lane] * dl[64 + lane]), s2 = wave_sum(dl[128 + lane] * dl[192 + lane]);
            const float lam_init = 0.8f - 0.6f * expf(-0.3f * (float)L);
            const float lam = expf(s1) - expf(s2) + lam_init, post = 1.0f - lam_init;
            const int h = lane >> 4, d8 = (lane & 15) * 8;
            const f32x4 g0 = *(const f32x4*)(A->df_subln_g + L * 128 + d8), g1 = *(const f32x4*)(A->df_subln_g + L * 128 + d8 + 4);
            for (int m = gw; m < R_ALL; m += NGW) {
                if (L == 1 && m >= LAT) break;
                const float* o0 = WSP(float, WS_OC) + (size_t)m * 1024 + (2 * h) * 128 + d8; const float* o1 = o0 + 128;
                const f32x4 a0 = *(const f32x4*)o0, a1 = *(const f32x4*)(o0 + 4), b0 = *(const f32x4*)o1, b1 = *(const f32x4*)(o1 + 4);
                const f32x4 x0 = a0 - lam * b0, x1 = a1 - lam * b1;
                float ss = (x0.x * x0.x + x0.y * x0.y) + (x0.z * x0.z + x0.w * x0.w) + (x1.x * x1.x + x1.y * x1.y) + (x1.z * x1.z + x1.w * x1.w);
                ss += lane_xor<1>(ss); ss += lane_xor<2>(ss); ss += lane_xor<4>(ss); ss += lane_xor<8>(ss);
                const float rinv = rsqrtf(ss * (1.0f / 128.0f) + NORM_EPS) * post;
                const f32x4 y0 = x0 * rinv * g0, y1 = x1 * rinv * g1;
                u32x4 w; w.x = cvt_pk_bf16(y0.x, y0.y); w.y = cvt_pk_bf16(y0.z, y0.w); w.z = cvt_pk_bf16(y1.x, y1.y); w.w = cvt_pk_bf16(y1.z, y1.w);
                *(u32x4*)(WSP(bf16_t, WS_O) + (size_t)m * D + 1536 + h * 128 + d8) = w;
            }
        }
        SEAM(pb + 4);
        if (EN(6) && IN(pb + 5)) { PH_BEGIN
            pg8::Gemm g{WSP(bf16_t, WS_O), WSP(bf16_t, WS_WOUT) + (size_t)L * D * D, D, D, nullptr}; pg8::StaticOrder S; S.init(MROWS, D, G, bx);
            pg8::EpiResGate E{(L == 0) ? A->x : A->out, (L == 0) ? A->ctx : WSP(float, WS_XC), A->out, WSP(float, WS_XC), modL + 2 * D};
            pg8::gemm_phase<pg8::EpiResGate, pg8::StaticOrder, false>(lds, g, S, E);
        }
        SEAM(pb + 5);
        if (EN(7) && IN(pb + 6)) { PH_BEGIN
            const float* gain = A->norm2_g + L * D;
            LAS float* RT = (LAS float*)lds;
            if (L == 1) { for (int i = tid; i < D * NE; i += 512) RT[(i & 7) * D + (i >> 3)] = A->moe_router[i]; __syncthreads(); }
            for (int m = gw; m < MROWS; m += NGW) {
                const bool isctx = m >= LAT; const int b = isctx ? 4 : (m >> 12);
                const float* xr = isctx ? WSP(float, WS_XC) + (size_t)(m - LAT) * D : A->out + (size_t)m * D;
                const float* sh = modL + (size_t)b * 12288 + 3 * D; const float* sc = sh + D;
                f32x4 v[8]; float ss = 0.f;
#pragma unroll
                for (int j = 0; j < 8; ++j) { v[j] = *(const f32x4*)(xr + 256 * j + 4 * lane); ss += (v[j].x * v[j].x + v[j].y * v[j].y) + (v[j].z * v[j].z + v[j].w * v[j].w); }
                const float rinv = rsqrtf(wave_sum(ss) * (1.0f / D) + NORM_EPS);
                bf16_t* orow = WSP(bf16_t, WS_H) + (size_t)m * D;
#pragma unroll
                for (int j = 0; j < 8; ++j) { const int cidx = 256 * j + 4 * lane; const f32x4 gq = *(const f32x4*)(gain + cidx), s4 = *(const f32x4*)(sc + cidx), h4 = *(const f32x4*)(sh + cidx);
                    v[j] = v[j] * rinv * gq * (1.0f + s4) + h4; u32x2 w; w.x = cvt_pk_bf16(v[j].x, v[j].y); w.y = cvt_pk_bf16(v[j].z, v[j].w); *(u32x2*)(orow + cidx) = w; }
                if (L == 1) {
                    float lg[8];
#pragma unroll
                    for (int e = 0; e < 8; ++e) { float s = 0.f;
#pragma unroll
                        for (int j = 0; j < 8; ++j) { const f32x4 r4 = *(const LAS f32x4*)(RT + e * D + 256 * j + 4 * lane); s += (v[j].x * r4.x + v[j].y * r4.y) + (v[j].z * r4.z + v[j].w * r4.w); }
                        lg[e] = wave_sum(s); }
                    int e0 = 0; float b0 = lg[0];
#pragma unroll
                    for (int e = 1; e < 8; ++e) if (lg[e] > b0) { b0 = lg[e]; e0 = e; }
                    int e1 = -1; float b1 = -3.0e38f;
#pragma unroll
                    for (int e = 0; e < 8; ++e) if (e != e0 && lg[e] > b1) { b1 = lg[e]; e1 = e; }
                    const float ex = expf(b1 - b0), p0 = 1.0f / (1.0f + ex), p1 = ex / (1.0f + ex);
                    if (lane == 0) { WSP(int, WS_ROUTE_E)[m] = e0 | (e1 << 8); WSP(f32x2, WS_ROUTE_P)[m] = (f32x2){p0, p1}; }
                }
            }
            if (L == 1) __syncthreads();
        }
        SEAM(pb + 6);
        if (L == 0) {
            if (EN(8) && IN(pb + 7)) { PH_BEGIN
                pg8::Gemm g{WSP(bf16_t, WS_H), WSP(bf16_t, WS_W13), FF2, D, nullptr}; pg8::StaticOrder S; S.init(R_ALL, FF2, G, bx);
                pg8::EpiSwiGLU E{WSP(bf16_t, WS_G)};
                pg8::gemm_phase<pg8::EpiSwiGLU, pg8::StaticOrder, false>(lds, g, S, E);
            }
            SEAM(pb + 7);
            if (EN(9) && IN(pb + 8)) { PH_BEGIN
                pg8::Gemm g{WSP(bf16_t, WS_G), WSP(bf16_t, WS_W2), D, FF, nullptr}; pg8::StaticOrder S; S.init(R_ALL, D, G, bx);
                pg8::EpiResGate E{A->out, WSP(float, WS_XC), A->out, WSP(float, WS_XC), modL + 5 * D};
                pg8::gemm_phase<pg8::EpiResGate, pg8::StaticOrder, false>(lds, g, S, E);
            }
            SEAM(pb + 8);
        } else {
            if (EN(10) && IN(pb + 7)) { PH_BEGIN
                LAS int* cnt = (LAS int*)lds;
                LAS int* tot = (LAS int*)(lds + 16384);
                int myc[8] = {0, 0, 0, 0, 0, 0, 0, 0};
                for (int i = 0; i < 32; ++i) { const int ee = WSP(int, WS_ROUTE_E)[tid * 32 + i]; const int a = ee & 255, b2 = ee >> 8;
#pragma unroll
                    for (int e = 0; e < 8; ++e) myc[e] += (a == e) + (b2 == e); }
#pragma unroll
                for (int e = 0; e < 8; ++e) cnt[tid * 8 + e] = myc[e];
                __syncthreads();
                {
                    int loc[8]; int s = 0;
#pragma unroll
                    for (int q = 0; q < 8; ++q) { loc[q] = cnt[(lane * 8 + q) * 8 + wave]; s += loc[q]; }
                    LAS int* wsum = (LAS int*)(lds + 20480) + wave * 64;
                    wsum[lane] = s; LDS_WAIT();
                    int run = 0, incl = 0;
                    for (int q = 0; q < 64; ++q) { const int t = wsum[q]; if (q < lane) run += t; incl += t; }
#pragma unroll
                    for (int q = 0; q < 8; ++q) { cnt[(lane * 8 + q) * 8 + wave] = run; run += loc[q]; }
                    if (lane == 63) tot[wave] = incl;
                }
                __syncthreads();
                if (tid == 0) { int off = 0; for (int e = 0; e < 8; ++e) { tot[8 + e] = off; off += (tot[e] + 255) & ~255; } tot[16] = off >> 8; }
                __syncthreads();
                {
                    int tmod = tid; while (tmod >= G) tmod -= G;
                    if (tmod == bx) {
                        int base[8];
#pragma unroll
                        for (int e = 0; e < 8; ++e) base[e] = tot[8 + e] + cnt[tid * 8 + e];
                        for (int i = 0; i < 32; ++i) { const int t = tid * 32 + i; const int ee = WSP(int, WS_ROUTE_E)[t]; const int a = ee & 255, b2 = ee >> 8; int sa = 0, sb = 0;
#pragma unroll
                            for (int e = 0; e < 8; ++e) { if (a == e) { sa = base[e]; base[e] += 1; } if (b2 == e) { sb = base[e]; base[e] += 1; } }
                            WSP(int, WS_GROW)[sa] = t; WSP(int, WS_GROW)[sb] = t; WSP(int, WS_SLOT_OF)[2 * t] = sa; WSP(int, WS_SLOT_OF)[2 * t + 1] = sb; }
                    }
                }
                if (bx == 0) {
                    for (int e = 0; e < 8; ++e) { const int n = tot[e], np = (n + 255) & ~255, off = tot[8 + e];
                        for (int s = n + tid; s < np; s += 512) WSP(int, WS_GROW)[off + s] = 0;
                        for (int p = tid; p < (np >> 8); p += 512) WSP(int, WS_PANE)[(off >> 8) + p] = e; }
                    if (tid == 0) WSP(int, WS_PANE)[255] = tot[16];
                }
                __syncthreads();
            }
            SEAM(pb + 7);
            if (EN(11) && IN(pb + 8)) { PH_BEGIN
                pg8::Gemm g{WSP(bf16_t, WS_H), WSP(bf16_t, WS_MW13), FF2, D, WSP(int, WS_GROW)}; pg8::MoeOrder S{__hip_atomic_load(WSP(int, WS_PANE) + 255, __ATOMIC_RELAXED, __HIP_MEMORY_SCOPE_AGENT), FF2 / 256, G, bx, WSP(int, WS_PANE)};
                pg8::EpiSwiGLU E{WSP(bf16_t, WS_G)};
                pg8::gemm_phase<pg8::EpiSwiGLU, pg8::MoeOrder, true>(lds, g, S, E);
            }
            SEAM(pb + 8);
            if (EN(12) && IN(pb + 9)) { PH_BEGIN
                pg8::Gemm g{WSP(bf16_t, WS_G), WSP(bf16_t, WS_MW2), D, FF, nullptr}; pg8::MoeOrder S{__hip_atomic_load(WSP(int, WS_PANE) + 255, __ATOMIC_RELAXED, __HIP_MEMORY_SCOPE_AGENT), D / 256, G, bx, WSP(int, WS_PANE)};
                pg8::EpiF32 E{WSP(float, WS_Y), D};
                pg8::gemm_phase<pg8::EpiF32, pg8::MoeOrder, false>(lds, g, S, E);
            }
            SEAM(pb + 9);
            if (EN(13) && IN(pb + 10)) { PH_BEGIN
                for (int m = gw; m < LAT; m += NGW) {
                    const int b = m >> 12; const float* gt = modL + (size_t)b * 12288 + 5 * D;
                    const int s0 = WSP(int, WS_SLOT_OF)[2 * m], s1 = WSP(int, WS_SLOT_OF)[2 * m + 1]; const f32x2 pp = WSP(f32x2, WS_ROUTE_P)[m];
                    const int ee = WSP(int, WS_ROUTE_E)[m]; const bool swap = (ee >> 8) < (ee & 255);
                    const float* ya = WSP(float, WS_Y) + (size_t)(swap ? s1 : s0) * D; const float* yb = WSP(float, WS_Y) + (size_t)(swap ? s0 : s1) * D; const float pa = swap ? pp.y : pp.x, pbb = swap ? pp.x : pp.y;
                    float* xr = A->out + (size_t)m * D;
#pragma unroll
                    for (int j = 0; j < 8; ++j) { const int cidx = 256 * j + 4 * lane; const f32x4 xv = *(const f32x4*)(xr + cidx), a4 = *(const f32x4*)(ya + cidx), b4 = *(const f32x4*)(yb + cidx), g4 = *(const f32x4*)(gt + cidx);
                        *(f32x4*)(xr + cidx) = xv + g4 * (pa * a4 + pbb * b4); }
                }
            }
        }
    }
#undef modL
#undef IN
#undef SEAM
}

extern "C" void kernel_launch(void* const* d_in, const int* in_sizes, int n_in, void* d_out, int out_size, void* d_ws, size_t ws_size, hipStream_t stream) {
    static int grid = 0;
    if (grid == 0) {
        if (n_in != 27 || out_size != LAT * D || ws_size < WS_END) { fprintf(stderr, "kernel_launch: unexpected shapes (n_in %d out %d ws %zu need %zu)\n", n_in, out_size, ws_size, (size_t)WS_END); grid = -1; return; }
        int dev = 0, cus = 0, per_cu = 0;
        if (hipGetDevice(&dev) != hipSuccess || hipDeviceGetAttribute(&cus, hipDeviceAttributeMultiprocessorCount, dev) != hipSuccess) { grid = -1; return; }
        if (hipFuncSetAttribute((const void*)mk_fwd, hipFuncAttributeMaxDynamicSharedMemorySize, LDS_BYTES) != hipSuccess) { fprintf(stderr, "kernel_launch: hipFuncSetAttribute failed\n"); grid = -1; return; }
        if (hipOccupancyMaxActiveBlocksPerMultiprocessor(&per_cu, (const void*)mk_fwd, 512, LDS_BYTES) != hipSuccess || per_cu < 1) fprintf(stderr, "kernel_launch: occupancy query reports %d\n", per_cu);
        (void)hipGetLastError();
        grid = cus;
    }
    if (grid < 0) return;
    if (hipMemsetAsync((char*)d_ws + WS_CTL, 0, CTL_ZERO_BYTES, stream) != hipSuccess) return;
    Args a{};
    const float** ap = (const float**)&a;
    for (int i = 0; i < 27; ++i) ap[i] = (const float*)d_in[i];
    a.out = (float*)d_out; a.ws = (unsigned char*)d_ws;
#if MK_PER_PHASE
    static const int ids[] = {0, 1, 2, 3, 4, 5, 6, 7, 8, 9, 17, 18, 19, 20, 21, 22, 23, 24, 25, 26, 27};
    for (int k = 0; k < (int)(sizeof(ids) / sizeof(ids[0])); ++k) { a.ph_lo = ids[k]; a.ph_hi = ids[k] + 1; hipLaunchKernelGGL(mk_fwd, dim3(grid), dim3(512), LDS_BYTES, stream, a); }
#else
    a.ph_lo = 0; a.ph_hi = 64;
    hipLaunchKernelGGL(mk_fwd, dim3(grid), dim3(512), LDS_BYTES, stream, a);
#endif
    const hipError_t le = hipPeekAtLastError();
    if (le != hipSuccess) fprintf(stderr, "kernel_launch: launch failed: %s\n", hipGetErrorName(le));
}
```

```cpp
#include <hip/hip_runtime.h>
#include <cstdio>
#include <cstdint>

#ifndef MK_PER_PHASE
#define MK_PER_PHASE 0
#endif
#ifndef DUP_ATT
#define DUP_ATT 0
#endif
#ifndef DUP_P0
#define DUP_P0 0
#endif

#define GAS __attribute__((address_space(1)))
#define LAS __attribute__((address_space(3)))
typedef unsigned short bf16_t;
typedef short bf16x8 __attribute__((ext_vector_type(8)));
typedef short s16x4 __attribute__((ext_vector_type(4)));
typedef float f32x4 __attribute__((ext_vector_type(4)));
typedef float f32x2 __attribute__((ext_vector_type(2)));
typedef float f32x16 __attribute__((ext_vector_type(16)));
typedef unsigned u32x4 __attribute__((ext_vector_type(4)));
typedef unsigned u32x2 __attribute__((ext_vector_type(2)));

constexpr int D = 2048, NB = 4, SEQ = 4096, LAT = NB * SEQ, CTXL = 256, NCTX = NB * CTXL, R_ALL = LAT + NCTX;
constexpr int INW = 5120, FF = 5632, FF2 = 2 * FF, NE = 8;
constexpr int C_QA = 0, C_KA = 768, C_VA = 1536, C_QB = 2304, C_KB = 3072, C_VB = 3328, C_QC = 3584, C_KC = 4096, C_VC = 4608;
constexpr float NORM_EPS = 1e-6f, LOG2E = 1.4426950408889634f;
constexpr int MAXPAN = 136;

constexpr size_t MiB = 1u << 20;
constexpr size_t WS_CTL = 0, CTL_ZERO_BYTES = 1 * MiB;
constexpr size_t WS_MOD = 1 * MiB;
constexpr size_t WS_ROUTE_E = 2 * MiB;
constexpr size_t WS_ROUTE_P = WS_ROUTE_E + 65536;
constexpr size_t WS_SLOT_OF = WS_ROUTE_P + 131072;
constexpr size_t WS_GROW = WS_SLOT_OF + 131072;
constexpr size_t WS_PANE = WS_GROW + 262144;
constexpr size_t WS_XC = 3 * MiB;
constexpr size_t WS_WIN = WS_XC + 8 * MiB;
constexpr size_t WS_WOUT = WS_WIN + 40 * MiB;
constexpr size_t WS_W13 = WS_WOUT + 16 * MiB;
constexpr size_t WS_W2 = WS_W13 + 44 * MiB;
constexpr size_t WS_MW13 = WS_W2 + 22 * MiB;
constexpr size_t WS_MW2 = WS_MW13 + 352 * MiB;
constexpr size_t WS_H = WS_MW2 + 176 * MiB;
constexpr size_t WS_P = WS_H + 68 * MiB;
constexpr size_t WS_O = WS_P + 170 * MiB;
constexpr size_t WS_OC = WS_O + 68 * MiB;
constexpr size_t WS_Y = WS_P;
constexpr size_t WS_G = WS_OC + 68 * MiB;
constexpr size_t WS_END = WS_G + 374 * MiB;
static_assert((size_t)MAXPAN * 256 * D * 4 <= 306 * MiB, "Y overlay");
static_assert((size_t)MAXPAN * 256 * FF * 2 <= 374 * MiB, "G size");
constexpr int CW_BAR = 4096;
constexpr int CW_Q = 16384;

constexpr int RING_BYTES = 131072, LDSCTL_OFF = RING_BYTES, MISC_OFF = LDSCTL_OFF + 320, LDS_BYTES = 147456;

#define LDS_WAIT() asm volatile("s_waitcnt lgkmcnt(0)" ::: "memory")
#define VM_WAIT() asm volatile("s_waitcnt vmcnt(0)" ::: "memory")
#define RLX_AGENT __ATOMIC_RELAXED, __HIP_MEMORY_SCOPE_AGENT

__device__ __forceinline__ unsigned cvt_pk_bf16(float lo, float hi) { unsigned r; asm volatile("v_cvt_pk_bf16_f32 %0, %1, %2" : "=v"(r) : "v"(lo), "v"(hi)); return r; }
__device__ __forceinline__ float bf2f(unsigned short b) { return __uint_as_float(((unsigned)b) << 16); }
__device__ __forceinline__ unsigned short f2bf(float f) { unsigned u = __float_as_uint(f); return (unsigned short)((u + 0x7fffu + ((u >> 16) & 1u)) >> 16); }
template <int X> __device__ __forceinline__ float lane_xor(float v) {
    if constexpr (X == 1) return __builtin_bit_cast(float, __builtin_amdgcn_mov_dpp(__builtin_bit_cast(int, v), 0xB1, 0xF, 0xF, true));
    else if constexpr (X == 2) return __builtin_bit_cast(float, __builtin_amdgcn_mov_dpp(__builtin_bit_cast(int, v), 0x4E, 0xF, 0xF, true));
    else return __builtin_bit_cast(float, __builtin_amdgcn_ds_swizzle(__builtin_bit_cast(int, v), (X << 10) | 0x1f));
}
__device__ __forceinline__ float half_sum32(float v) {
    v += lane_xor<1>(v); v += lane_xor<2>(v); v += lane_xor<4>(v); v += lane_xor<8>(v); v += lane_xor<16>(v); return v;
}
__device__ __forceinline__ float wave_sum(float v) {
    v = half_sum32(v);
    auto rr = __builtin_amdgcn_permlane32_swap(__float_as_uint(v), __float_as_uint(v), false, false);
    return __uint_as_float(rr[0]) + __uint_as_float(rr[1]);
}

namespace pg8 {
constexpr int BM = 256, BK = 64, HALF = 128, HTB = HALF * BK * 2, STAGE_BYTES = 8 * HTB, NXCD = 8, WGM = 8;
__host__ __device__ __forceinline__ int lds_byte(int r, int c) { const int st = (r >> 4) * 2 + (c >> 5), rr = r & 15, cc = c & 31, ob = rr * 64 + cc * 2; return st * 1024 + (ob ^ (((ob >> 9) & 1) << 5)); }
__host__ __device__ __forceinline__ void stage_rc(int b, int& R, int& C) { const int st = b / 1024, sb = b % 1024, swz = sb ^ (((sb >> 9) & 1) << 5); R = (st >> 1) * 16 + swz / 64; C = (st & 1) * 32 + (swz % 64) / 2; }
__host__ __device__ __forceinline__ int perm32(int rho) { const int n = rho >> 4, i = rho & 15; return 8 * (i >> 2) + 4 * n + (i & 3); }

struct Unit { int pm, pn, e; };
struct Gemm { const bf16_t* A; const bf16_t* Bt; int N, K; const int* rowmap; };

struct StaticOrder {
    int nM, nN, nwg, G, c;
    __host__ __device__ void init(int M, int N, int G_, int c_) { nM = M / BM; nN = N / BM; nwg = nM * nN; G = G_; c = c_; }
    __host__ __device__ bool next(int i, Unit& u) const {
        const long L = (long)i * G + c; if (L >= nwg) return false;
        int wgid = (int)L; { const int q = nwg / NXCD, r = nwg % NXCD, xcd = wgid % NXCD, off = wgid / NXCD; wgid = (xcd < r ? xcd * (q + 1) : r * (q + 1) + (xcd - r) * q) + off; }
        const int nig = WGM * nN, gid = wgid / nig, fm = gid * WGM, gsz = (nM - fm) < WGM ? (nM - fm) : WGM;
        u.pm = fm + ((wgid % nig) % gsz); u.pn = (wgid % nig) / gsz; u.e = 0; return true;
    }
};
struct MoeOrder {
    int npan, nN, G, c; const int* pane;
    __device__ bool next(int i, Unit& u) const {
        const long L = (long)i * G + c; if (L >= (long)npan * nN) return false;
        u.pm = (int)(L / nN); u.pn = (int)(L % nN); u.e = __hip_atomic_load(pane + u.pm, __ATOMIC_RELAXED, __HIP_MEMORY_SCOPE_AGENT); return true;
    }
};

struct EpiBf16 {
    static constexpr bool PERM = true;
    bf16_t* O; int ldc;
    __device__ __forceinline__ void operator()(const f32x4 (&acc)[2][2][4][2], const Unit& u, int wr, int wc, int fr, int fq) const {
        const int row0 = u.pm * BM + wr * 64 + fr, col0 = u.pn * BM + wc * 32 + 8 * fq;
#pragma unroll
        for (int ai = 0; ai < 2; ++ai)
#pragma unroll
            for (int m = 0; m < 4; ++m) { bf16_t* rowp = O + (size_t)(row0 + ai * HALF + m * 16) * ldc + col0;
#pragma unroll
                for (int bj = 0; bj < 2; ++bj) { const f32x4 v0 = acc[ai][bj][m][0], v1 = acc[ai][bj][m][1];
                    u32x4 w; w.x = cvt_pk_bf16(v0[0], v0[1]); w.y = cvt_pk_bf16(v0[2], v0[3]); w.z = cvt_pk_bf16(v1[0], v1[1]); w.w = cvt_pk_bf16(v1[2], v1[3]);
                    *(u32x4*)(rowp + bj * HALF) = w; } }
    }
};
struct EpiF32 {
    static constexpr bool PERM = false;
    float* C; int ldc;
    __device__ __forceinline__ void operator()(const f32x4 (&acc)[2][2][4][2], const Unit& u, int wr, int wc, int fr, int fq) const {
        const int row0 = u.pm * BM + wr * 64 + fr, col0 = u.pn * BM + wc * 32 + 4 * fq;
#pragma unroll
        for (int ai = 0; ai < 2; ++ai)
#pragma unroll
            for (int m = 0; m < 4; ++m) { float* rowp = C + (size_t)(row0 + ai * HALF + m * 16) * ldc + col0;
#pragma unroll
                for (int bj = 0; bj < 2; ++bj)
#pragma unroll
                    for (int n = 0; n < 2; ++n) *(f32x4*)(rowp + bj * HALF + n * 16) = acc[ai][bj][m][n]; }
    }
};
struct EpiResGate {
    static constexpr bool PERM = false;
    const float* xin_lat; const float* xin_ctx; float* xout_lat; float* xout_ctx; const float* gate;
    __device__ __forceinline__ void operator()(const f32x4 (&acc)[2][2][4][2], const Unit& u, int wr, int wc, int fr, int fq) const {
        const bool isctx = u.pm >= (LAT / BM); const int b = isctx ? 4 : (u.pm >> 4);
        const int rowl = (isctx ? (u.pm - LAT / BM) : u.pm) * BM + wr * 64 + fr, col0 = u.pn * BM + wc * 32 + 4 * fq;
        const float* xi = isctx ? xin_ctx : xin_lat; float* xo = isctx ? xout_ctx : xout_lat; const float* gp = gate + (size_t)b * 12288 + col0;
#pragma unroll
        for (int bj = 0; bj < 2; ++bj)
#pragma unroll
            for (int n = 0; n < 2; ++n) { const f32x4 gv = *(const f32x4*)(gp + bj * HALF + n * 16);
#pragma unroll
                for (int ai = 0; ai < 2; ++ai) {
#pragma unroll
                    for (int m = 0; m < 4; ++m) { const size_t off = (size_t)(rowl + ai * HALF + m * 16) * D + col0 + bj * HALF + n * 16;
                        const f32x4 bs = *(const f32x4*)(xi + off); *(f32x4*)(xo + off) = bs + gv * acc[ai][bj][m][n]; }
                    asm volatile("" ::: "memory"); } }
    }
};
struct EpiSwiGLU {
    static constexpr bool PERM = false;
    bf16_t* G;
    __device__ __forceinline__ void operator()(const f32x4 (&acc)[2][2][4][2], const Unit& u, int wr, int wc, int fr, int fq) const {
        const int row0 = u.pm * BM + wr * 64 + fr, col0 = u.pn * 128 + wc * 16 + 4 * fq;
#pragma unroll
        for (int ai = 0; ai < 2; ++ai)
#pragma unroll
            for (int m = 0; m < 4; ++m) { bf16_t* rowp = G + (size_t)(row0 + ai * HALF + m * 16) * FF + col0;
#pragma unroll
                for (int bj = 0; bj < 2; ++bj) { const f32x4 a = acc[ai][bj][m][0], b = acc[ai][bj][m][1]; float r[4];
#pragma unroll
                    for (int j = 0; j < 4; ++j) { const float s = __builtin_amdgcn_rcpf(1.0f + __builtin_amdgcn_exp2f(-a[j] * LOG2E)); r[j] = a[j] * s * b[j]; }
                    u32x2 w; w.x = cvt_pk_bf16(r[0], r[1]); w.y = cvt_pk_bf16(r[2], r[3]);
                    *(u32x2*)(rowp + bj * 64) = w; } }
    }
};

template <class Epi, class Sched, bool GATHER, bool ALIGN_EPI = true>
__device__ __forceinline__ void gemm_phase(LAS unsigned char* lds, const Gemm g, const Sched& S, const Epi& E) {
    int tid = threadIdx.x; asm volatile("" : "+v"(tid));
    const int wid = __builtin_amdgcn_readfirstlane(tid >> 6), lane = tid & 63, wr = wid >> 2, wc = wid & 3, fr = lane & 15, fq = lane >> 4;
    const int K = g.K, nt = K / BK;
    int RA[2], CA[2]; unsigned voffA[2], voffB[2];
#pragma unroll
    for (int i = 0; i < 2; ++i) { int R, C; stage_rc(tid * 16 + i * 8192, R, C); const int Rb = Epi::PERM ? ((R & ~31) + perm32(R & 31)) : R;
        RA[i] = R; CA[i] = C; voffA[i] = (unsigned)(R * K + C) * 2u; voffB[i] = (unsigned)(Rb * K + C) * 2u; }
    const size_t kstep = (size_t)(BK * 2);
    const size_t hstep = (size_t)HALF * K * 2;
    const size_t tstep = 2 * hstep;
    const unsigned ldsw = (unsigned)wid * 1024u;
    const int aoff = lds_byte(wr * 64 + fr, fq * 8), boff = lds_byte(wc * 32 + fr, fq * 8);
#define PG8_SA(b, h) (((b) * 2 + (h)) * HTB)
#define PG8_SB(b, h) ((4 + (b) * 2 + (h)) * HTB)
#define PG8_STAGE(bufoff, gbase, voff) do { _Pragma("unroll") for (int _i = 0; _i < 2; ++_i) \
        __builtin_amdgcn_global_load_lds((const unsigned*)((const char*)(gbase) + (voff)[_i]), (LAS unsigned*)(lds + (bufoff) + ldsw + _i * 8192), 16, 0, 0); } while (0)
#define PG8_STAGE_A(bufoff, h, gptr, OO) do { if constexpr (GATHER) { PG8_STAGE(bufoff, gptr, (OO)[h]); } else { PG8_STAGE(bufoff, (gptr) + ((h) ? hstep : 0), voffA); } } while (0)
#define PG8_MKOFF(u, o) do { if constexpr (GATHER) { _Pragma("unroll") for (int _h = 0; _h < 2; ++_h) _Pragma("unroll") for (int _i = 0; _i < 2; ++_i) { \
        const int _row = g.rowmap[(u).pm * BM + _h * HALF + RA[_i]]; (o)[_h][_i] = ((unsigned)_row * (unsigned)K + (unsigned)CA[_i]) * 2u; } } } while (0)
#define PG8_LDA(dst, b, h) do { _Pragma("unroll") for (int m = 0; m < 4; ++m) _Pragma("unroll") for (int k = 0; k < 2; ++k) dst[m][k] = *(const LAS bf16x8*)(lds + PG8_SA(b, h) + aoff + m * 2048 + k * 1024); } while (0)
#define PG8_LDB(dst, b, h) do { _Pragma("unroll") for (int n = 0; n < 2; ++n) _Pragma("unroll") for (int k = 0; k < 2; ++k) dst[n][k] = *(const LAS bf16x8*)(lds + PG8_SB(b, h) + boff + n * 2048 + k * 1024); } while (0)
#define PG8_MMA(ai, bj, At, Bt) do { __builtin_amdgcn_s_setprio(1); _Pragma("unroll") for (int m = 0; m < 4; ++m) _Pragma("unroll") for (int n = 0; n < 2; ++n) _Pragma("unroll") for (int k = 0; k < 2; ++k) \
        acc[ai][bj][m][n] = __builtin_amdgcn_mfma_f32_16x16x32_bf16(Bt[n][k], At[m][k], acc[ai][bj][m][n], 0, 0, 0); __builtin_amdgcn_s_setprio(0); } while (0)
#define PG8_WAIT_V(n) asm volatile("s_waitcnt vmcnt(" #n ")" ::: "memory")
#define PG8_WAIT_L(n) asm volatile("s_waitcnt lgkmcnt(" #n ")" ::: "memory")
#define PG8_BAR __builtin_amdgcn_s_barrier()
#define PG8_SCHED __builtin_amdgcn_sched_barrier(0)
    Unit cur, nxt; int ui = 0;
    if (!S.next(0, cur)) return;
    f32x4 acc[2][2][4][2];
#pragma unroll
    for (int a = 0; a < 2; ++a)
#pragma unroll
        for (int b = 0; b < 2; ++b)
#pragma unroll
            for (int m = 0; m < 4; ++m)
#pragma unroll
                for (int n = 0; n < 2; ++n) acc[a][b][m][n] = (f32x4){0.f, 0.f, 0.f, 0.f};
    bf16x8 At[4][2], B0[2][2], B1[2][2];
    unsigned cO[2][2] = {{0u, 0u}, {0u, 0u}}, nO[2][2] = {{0u, 0u}, {0u, 0u}};
    PG8_MKOFF(cur, cO);
    const char* cA = (const char*)g.A + (GATHER ? (size_t)0 : (size_t)cur.pm * tstep);
    const char* cB = (const char*)g.Bt + ((size_t)cur.e * g.N + (size_t)cur.pn * BM) * K * 2;
    PG8_STAGE(PG8_SB(0, 0), cB, voffB); PG8_STAGE(PG8_SB(0, 1), cB + hstep, voffB); PG8_STAGE_A(PG8_SA(0, 0), 0, cA, cO); PG8_STAGE_A(PG8_SA(0, 1), 1, cA, cO);
    if (wr == 1) PG8_BAR;
    PG8_WAIT_V(2); PG8_BAR;
    PG8_STAGE(PG8_SB(1, 0), cB + kstep, voffB); PG8_STAGE_A(PG8_SA(1, 0), 0, cA + kstep, cO); PG8_STAGE(PG8_SB(1, 1), cB + hstep + kstep, voffB);
    PG8_WAIT_V(6); PG8_BAR;
    for (;;) {
        const bool has_next = S.next(ui + 1, nxt);
        if (has_next) { PG8_MKOFF(nxt, nO); } else {
#pragma unroll
            for (int h = 0; h < 2; ++h)
#pragma unroll
                for (int i = 0; i < 2; ++i) nO[h][i] = cO[h][i]; }
        const char* nA = (has_next && !GATHER) ? (const char*)g.A + (size_t)nxt.pm * tstep : cA;
        const char* nB = has_next ? (const char*)g.Bt + ((size_t)nxt.e * g.N + (size_t)nxt.pn * BM) * K * 2 : cB;
        for (int t = 0; t < nt; t += 2) {
            const bool last = (t == nt - 2);
            const char* a1 = cA + (size_t)(t + 1) * kstep;
            const char* a2 = last ? nA : cA + (size_t)(t + 2) * kstep; const char* b2 = last ? nB : cB + (size_t)(t + 2) * kstep;
            const char* a3 = a2 + kstep; const char* b3 = b2 + kstep;
            unsigned o2[2][2];
#pragma unroll
            for (int h = 0; h < 2; ++h)
#pragma unroll
                for (int i = 0; i < 2; ++i) o2[h][i] = last ? nO[h][i] : cO[h][i];
            PG8_LDB(B0, 0, 0); PG8_LDB(B1, 0, 1); PG8_SCHED; PG8_LDA(At, 0, 0); PG8_STAGE_A(PG8_SA(1, 1), 1, a1, cO);
            PG8_WAIT_V(8); PG8_WAIT_L(0); PG8_BAR; PG8_MMA(0, 0, At, B0); PG8_MMA(0, 1, At, B1); PG8_BAR; PG8_SCHED;
            PG8_LDA(At, 0, 1); PG8_STAGE(PG8_SB(0, 0), b2, voffB); PG8_STAGE(PG8_SB(0, 1), b2 + hstep, voffB); PG8_STAGE_A(PG8_SA(0, 0), 0, a2, o2);
            PG8_WAIT_V(8); PG8_WAIT_L(0); PG8_BAR; PG8_MMA(1, 0, At, B0); PG8_MMA(1, 1, At, B1); PG8_BAR; PG8_SCHED;
            PG8_LDB(B0, 1, 0); PG8_LDB(B1, 1, 1); PG8_SCHED; PG8_LDA(At, 1, 0); PG8_STAGE_A(PG8_SA(0, 1), 1, a2, o2);
            PG8_WAIT_V(8); PG8_WAIT_L(0); PG8_BAR; PG8_MMA(0, 0, At, B0); PG8_MMA(0, 1, At, B1); PG8_BAR; PG8_SCHED;
            PG8_LDA(At, 1, 1); PG8_STAGE(PG8_SB(1, 0), b3, voffB); PG8_STAGE(PG8_SB(1, 1), b3 + hstep, voffB); PG8_STAGE_A(PG8_SA(1, 0), 0, a3, o2);
            PG8_WAIT_V(8); PG8_WAIT_L(0); PG8_BAR; PG8_MMA(1, 0, At, B0); PG8_MMA(1, 1, At, B1); PG8_BAR; PG8_SCHED;
        }
        if constexpr (ALIGN_EPI) { if (wr == 0) PG8_BAR; }
        E(acc, cur, wr, wc, fr, fq);
        if (!has_next) break;
#pragma unroll
        for (int a = 0; a < 2; ++a)
#pragma unroll
            for (int b = 0; b < 2; ++b)
#pragma unroll
                for (int m = 0; m < 4; ++m)
#pragma unroll
                    for (int n = 0; n < 2; ++n) acc[a][b][m][n] = (f32x4){0.f, 0.f, 0.f, 0.f};
        cur = nxt; cA = nA; cB = nB; ++ui;
#pragma unroll
        for (int h = 0; h < 2; ++h)
#pragma unroll
            for (int i = 0; i < 2; ++i) cO[h][i] = nO[h][i];
        if constexpr (ALIGN_EPI) { if (wr == 1) PG8_BAR; }
    }
    PG8_WAIT_V(0);
    if constexpr (!ALIGN_EPI) { if (wr == 0) PG8_BAR; }
    PG8_BAR;
#undef PG8_SA
#undef PG8_SB
#undef PG8_STAGE
#undef PG8_STAGE_A
#undef PG8_MKOFF
#undef PG8_LDA
#undef PG8_LDB
#undef PG8_MMA
#undef PG8_WAIT_V
#undef PG8_WAIT_L
#undef PG8_BAR
#undef PG8_SCHED
}
}

namespace att {
__device__ __forceinline__ int crow(int r, int hi) { return (r & 3) + 8 * (r >> 2) + 4 * hi; }
__device__ __forceinline__ int v_st(int k, int c) { const int kk = (k & ~0xC) | ((k & 4) << 1) | ((k & 8) >> 1); return ((kk >> 3) * 4 + (c >> 5)) * 512 + ((kk & 7) * 32 + (c & 31)) * 2; }
__device__ __forceinline__ int v_rd_base(int lane) { return ((lane & 3) << 3) | (((lane >> 2) & 3) << 6) | (((lane >> 4) & 1) << 5) | (((lane >> 5) & 1) << 8); }
constexpr int v_rd_off(int d0, int ks, int half) { return d0 * 512 + ks * 4096 + half * 2048; }
template <int OFF> __device__ __forceinline__ s16x4 tr_read(int vb) {
    s16x4 r; asm volatile("ds_read_b64_tr_b16 %0, %1 offset:%2" : "=&v"(r) : "v"(vb), "i"(OFF) : "memory"); return r;
}
template <int D0> __device__ __forceinline__ void pv_one(f32x16& od, int vb, bf16x8 pa0, bf16x8 pa1, bf16x8 pa2, bf16x8 pa3) {
    const s16x4 l0 = tr_read<v_rd_off(D0, 0, 0)>(vb), h0 = tr_read<v_rd_off(D0, 0, 1)>(vb), l1 = tr_read<v_rd_off(D0, 1, 0)>(vb), h1 = tr_read<v_rd_off(D0, 1, 1)>(vb);
    const s16x4 l2 = tr_read<v_rd_off(D0, 2, 0)>(vb), h2 = tr_read<v_rd_off(D0, 2, 1)>(vb), l3 = tr_read<v_rd_off(D0, 3, 0)>(vb), h3 = tr_read<v_rd_off(D0, 3, 1)>(vb);
    asm volatile("s_waitcnt lgkmcnt(0)" ::: "memory"); __builtin_amdgcn_sched_barrier(0);
#define ATT_PK(L, H) (bf16x8){L[0], L[1], L[2], L[3], H[0], H[1], H[2], H[3]}
    od = __builtin_amdgcn_mfma_f32_32x32x16_bf16(pa0, ATT_PK(l0, h0), od, 0, 0, 0);
    od = __builtin_amdgcn_mfma_f32_32x32x16_bf16(pa1, ATT_PK(l1, h1), od, 0, 0, 0);
    od = __builtin_amdgcn_mfma_f32_32x32x16_bf16(pa2, ATT_PK(l2, h2), od, 0, 0, 0);
    od = __builtin_amdgcn_mfma_f32_32x32x16_bf16(pa3, ATT_PK(l3, h3), od, 0, 0, 0);
#undef ATT_PK
}
template <int DK> __device__ __forceinline__ void qkt(f32x16& p0, f32x16& p1, const LAS char* Ks, const bf16x8* qr, int r32, int hi) {
    p0 = (f32x16){0, 0, 0, 0, 0, 0, 0, 0, 0, 0, 0, 0, 0, 0, 0, 0}; p1 = p0;
#pragma unroll
    for (int d0 = 0; d0 < DK / 16; ++d0) { const int cb = (d0 * 16 + hi * 8) * 2;
        const bf16x8 b0 = *(const LAS bf16x8*)(Ks + r32 * (2 * DK) + (cb ^ ((r32 & 7) << 4)));
        const bf16x8 b1 = *(const LAS bf16x8*)(Ks + (32 + r32) * (2 * DK) + (cb ^ ((r32 & 7) << 4)));
        p0 = __builtin_amdgcn_mfma_f32_32x32x16_bf16(b0, qr[d0], p0, 0, 0, 0);
        p1 = __builtin_amdgcn_mfma_f32_32x32x16_bf16(b1, qr[d0], p1, 0, 0, 0); }
}
struct Cfg {
    int qrow0;
    int qcol, kcol, vcol;
    int ctxrow0;
    int latrow0;
    int lat0, nlat;
    int mode;
    int qb;
    int ocol;
    float sink2;
    const float* rpb;
};
constexpr int L_V = 0, L_K = 32768, L_WS = 65536, L_BIAS = 65536 + 2048 + 1024;

template <int DK, bool OUTF32>
__device__ __forceinline__ void attn_unit(LAS unsigned char* lds, const bf16_t* __restrict__ P, bf16_t* __restrict__ Obf, float* __restrict__ Of32, int ldo, const Cfg& c, int tid, int wid, int lane) {
    constexpr int ND = DK / 16;
    const int r32 = lane & 31, hi = lane >> 5;
    const LAS char* Vl = (const LAS char*)(lds + L_V); const LAS char* Kl = (const LAS char*)(lds + L_K);
    LAS float* wsf = (LAS float*)(lds + L_WS) + wid * 64; LAS float* biasl = (LAS float*)(lds + L_BIAS);
    const float C2 = (DK == 128 ? 0.08838834764831845f : 0.125f) * LOG2E;
    bf16x8 qr[ND];
    { const bf16_t* Pq = P + (size_t)(c.qrow0 + wid * 32 + r32) * INW + c.qcol + hi * 8;
#pragma unroll
      for (int d0 = 0; d0 < ND; ++d0) qr[d0] = *(const bf16x8*)(Pq + d0 * 16); }
    if (c.mode == 1) for (int i = tid; i < 465; i += 512) biasl[i] = c.rpb[i] * LOG2E;
    const int vsr = tid >> 4, vsc = (tid & 15) * 8;
    const int ksr = (DK == 128) ? (tid >> 4) : (tid >> 3), ksc = (DK == 128) ? (tid & 15) * 8 : (tid & 7) * 8;
    const int vst0 = v_st(vsr, vsc), vst1 = v_st(32 + vsr, vsc);
    const int kst0 = ksr * (2 * DK) + ((ksc * 2) ^ ((ksr & 7) << 4)), kst1 = (32 + ksr) * (2 * DK) + ((ksc * 2) ^ ((ksr & 7) << 4));
    const int vb0 = (int)(unsigned)(size_t)(lds + L_V) + v_rd_base(lane);
    const int NT = 4 + c.nlat;
    bf16x8 vs0, vs1, ks0, ks1;
#define ATT_SLOAD(j) do { const int _kr = ((j) < 4) ? (c.ctxrow0 + 64 * (j)) : (c.latrow0 + 64 * (c.lat0 + (j) - 4)); \
        const bf16_t* _v = P + (size_t)(_kr + vsr) * INW + c.vcol + vsc; vs0 = *(const bf16x8*)_v; vs1 = *(const bf16x8*)(_v + (size_t)32 * INW); \
        const bf16_t* _k = P + (size_t)(_kr + ksr) * INW + c.kcol + ksc; ks0 = *(const bf16x8*)_k; if (DK == 128) ks1 = *(const bf16x8*)(_k + (size_t)32 * INW); } while (0)
#define ATT_SWRITE(b) do { *(LAS bf16x8*)(lds + L_V + (b) * 16384 + vst0) = vs0; *(LAS bf16x8*)(lds + L_V + (b) * 16384 + vst1) = vs1; \
        *(LAS bf16x8*)(lds + L_K + (b) * 16384 + kst0) = ks0; if (DK == 128) *(LAS bf16x8*)(lds + L_K + (b) * 16384 + kst1) = ks1; } while (0)
    float m_reg = -1e30f, l_reg = 0.f;
    f32x16 o[4];
#pragma unroll
    for (int d = 0; d < 4; ++d) o[d] = (f32x16){0, 0, 0, 0, 0, 0, 0, 0, 0, 0, 0, 0, 0, 0, 0, 0};
    ATT_SLOAD(0); ATT_SWRITE(0); __syncthreads();
    const int q0w = 256 * c.qb + 32 * wid;
    const int qrw = 4 * c.qb + (wid >> 1);
    const int r0w = qrw - 4 < 0 ? 0 : (qrw - 4 > 56 ? 56 : qrw - 4);
    for (int j = 0; j < NT; ++j) {
        const int buf = j & 1;
        if (j + 1 < NT) ATT_SLOAD(j + 1);
        int tmode = 0; bool skip = false; const int lt = c.lat0 + j - 4;
        if (j >= 4) {
            if (c.mode == 1) { tmode = 1; skip = (lt < r0w) || (lt >= r0w + 8); }
            else if (c.mode == 2) { const int k0 = 64 * lt; skip = (k0 > q0w + 31 + 128) || (k0 + 63 < q0w - 128); tmode = ((k0 >= q0w + 31 - 128) && (k0 + 63 <= q0w + 128)) ? 0 : 2; }
        }
        if (!skip) {
            f32x16 p0, p1;
            qkt<DK>(p0, p1, Kl + buf * 16384, qr, r32, hi);
            if (tmode == 0) {
#pragma unroll
                for (int r = 0; r < 16; ++r) { p0[r] *= C2; p1[r] *= C2; }
            } else if (tmode == 1) {
                const int qc = 32 * (wid & 1) + r32;
                const int c0 = qc - 8 < 0 ? 0 : (qc - 8 > 48 ? 48 : qc - 8);
                int z = c0 - 4 * hi; asm volatile("" : "+v"(z));
                const int bbase = (lt - qrw + 7) * 31 + 15 - qc + 4 * hi;
#pragma unroll
                for (int r = 0; r < 16; ++r) { const int kcl = (r & 3) + 8 * (r >> 2);
                    const float b0 = biasl[bbase + kcl], b1 = biasl[bbase + kcl + 32];
                    p0[r] = ((unsigned)(kcl - z) < 16u) ? (p0[r] * C2 + b0) : -1e30f;
                    p1[r] = ((unsigned)(kcl + 32 - z) < 16u) ? (p1[r] * C2 + b1) : -1e30f; }
            } else {
                const int dq = q0w + r32 - 64 * lt - 4 * hi;
#pragma unroll
                for (int r = 0; r < 16; ++r) { const int kcl = (r & 3) + 8 * (r >> 2);
                    const int d0 = dq - kcl, d1 = d0 - 32;
                    p0[r] = ((unsigned)(d0 + 128) <= 256u) ? p0[r] * C2 : -1e30f;
                    p1[r] = ((unsigned)(d1 + 128) <= 256u) ? p1[r] * C2 : -1e30f; }
            }
            float pmax = p0[0];
#pragma unroll
            for (int r = 1; r < 16; ++r) pmax = fmaxf(pmax, p0[r]);
#pragma unroll
            for (int r = 0; r < 16; ++r) pmax = fmaxf(pmax, p1[r]);
            { auto rr = __builtin_amdgcn_permlane32_swap(__float_as_uint(pmax), __float_as_uint(pmax), false, false);
              pmax = fmaxf(__uint_as_float(rr[0]), __uint_as_float(rr[1])); }
            const float mn = fmaxf(m_reg, pmax), alpha = __builtin_amdgcn_exp2f(m_reg - mn);
            m_reg = mn;
            float ps = 0.f;
#pragma unroll
            for (int r = 0; r < 16; ++r) { p0[r] = __builtin_amdgcn_exp2f(p0[r] - mn); p1[r] = __builtin_amdgcn_exp2f(p1[r] - mn); ps += p0[r] + p1[r]; }
            { auto rr = __builtin_amdgcn_permlane32_swap(__float_as_uint(ps), __float_as_uint(ps), false, false);
              ps = __uint_as_float(rr[0]) + __uint_as_float(rr[1]); }
            l_reg = l_reg * alpha + ps;
            bf16x8 pa0, pa1, pa2, pa3;
#define ATT_PK4(Pv, BASE, OUT) do { unsigned a0 = cvt_pk_bf16(Pv[BASE + 0], Pv[BASE + 1]), a1 = cvt_pk_bf16(Pv[BASE + 2], Pv[BASE + 3]); \
    unsigned b0 = cvt_pk_bf16(Pv[BASE + 4], Pv[BASE + 5]), b1 = cvt_pk_bf16(Pv[BASE + 6], Pv[BASE + 7]); \
    auto r0 = __builtin_amdgcn_permlane32_swap(a0, b0, false, false); auto r1 = __builtin_amdgcn_permlane32_swap(a1, b1, false, false); \
    u32x4 w = {r0[0], r1[0], r0[1], r1[1]}; OUT = __builtin_bit_cast(bf16x8, w); } while (0)
            ATT_PK4(p0, 0, pa0); ATT_PK4(p0, 8, pa1); ATT_PK4(p1, 0, pa2); ATT_PK4(p1, 8, pa3);
#undef ATT_PK4
            if (__any(alpha < 1.f)) {
                if (hi == 0) wsf[r32] = alpha;
                LDS_WAIT();
#pragma unroll
                for (int r = 0; r < 16; ++r) { const float a = wsf[crow(r, hi)];
#pragma unroll
                    for (int d = 0; d < 4; ++d) o[d][r] *= a; }
                LDS_WAIT();
            }
            const int vb = vb0 + buf * 16384;
            pv_one<0>(o[0], vb, pa0, pa1, pa2, pa3); pv_one<1>(o[1], vb, pa0, pa1, pa2, pa3); pv_one<2>(o[2], vb, pa0, pa1, pa2, pa3); pv_one<3>(o[3], vb, pa0, pa1, pa2, pa3);
        }
        if (j + 1 < NT) ATT_SWRITE(buf ^ 1);
        __syncthreads();
    }
#undef ATT_SLOAD
#undef ATT_SWRITE
    if (c.sink2 > -1e29f) l_reg += __builtin_amdgcn_exp2f(c.sink2 - m_reg);
    if (hi == 0) wsf[32 + r32] = l_reg;
    LDS_WAIT();
    float rli[16];
#pragma unroll
    for (int r = 0; r < 16; ++r) rli[r] = 1.0f / wsf[32 + crow(r, hi)];
    LDS_WAIT();
    const int orow0 = c.qrow0 + wid * 32;
    if constexpr (OUTF32) {
#pragma unroll
        for (int r = 0; r < 16; ++r) { float* op = Of32 + (size_t)(orow0 + crow(r, hi)) * ldo + c.ocol + r32;
#pragma unroll
            for (int d0 = 0; d0 < 4; ++d0) op[d0 * 32] = o[d0][r] * rli[r]; }
    } else {
        const bool odd = (r32 & 1) != 0;
#pragma unroll
        for (int r = 0; r < 16; r += 2) {
            bf16_t* op = Obf + (size_t)(orow0 + crow(r, hi) + (odd ? 1 : 0)) * ldo + c.ocol + (r32 & ~1);
#pragma unroll
            for (int d0 = 0; d0 < 4; ++d0) { const float va = o[d0][r] * rli[r], vb2 = o[d0][r + 1] * rli[r + 1];
                const float snd = odd ? va : vb2; const float rcv = lane_xor<1>(snd);
                const unsigned w = odd ? cvt_pk_bf16(rcv, vb2) : cvt_pk_bf16(va, rcv);
                *(unsigned*)(op + d0 * 32) = w; }
        }
    }
}

constexpr float C_SCALE = 0.125f, C_C = C_SCALE * LOG2E, C_THR = 8.0f;
__device__ __forceinline__ void c_partialSM(f32x16& p0, f32x16& p1, float& m_reg, float& mn, float& alpha) {
    float pmax = p0[0];
#pragma unroll
    for (int r = 1; r < 16; ++r) pmax = fmaxf(pmax, p0[r]);
#pragma unroll
    for (int r = 0; r < 16; ++r) pmax = fmaxf(pmax, p1[r]);
    { auto rr = __builtin_amdgcn_permlane32_swap(__float_as_uint(pmax), __float_as_uint(pmax), false, false);
      pmax = fmaxf(__uint_as_float(rr[0]), __uint_as_float(rr[1])); }
    if (__builtin_expect(__all(pmax - m_reg <= C_THR / C_SCALE), 1)) { mn = m_reg; alpha = 1.f; }
    else { mn = fmaxf(m_reg, pmax); alpha = __builtin_amdgcn_exp2f((m_reg - mn) * C_C); m_reg = mn; }
    const float mnC = -mn * C_C;
#pragma unroll
    for (int r = 0; r < 16; ++r) p0[r] = fmaf(p0[r], C_C, mnC);
#pragma unroll
    for (int r = 0; r < 16; ++r) p1[r] = fmaf(p1[r], C_C, mnC);
#pragma unroll
    for (int r = 0; r < 16; ++r) p0[r] = __builtin_amdgcn_exp2f(p0[r]);
}
__device__ __forceinline__ void c_finishSM(f32x16& p0, f32x16& p1, float alpha, float& l_reg, bf16x8& pa0, bf16x8& pa1, bf16x8& pa2, bf16x8& pa3) {
#pragma unroll
    for (int r = 0; r < 16; ++r) p1[r] = __builtin_amdgcn_exp2f(p1[r]);
    float ps = 0.f;
#pragma unroll
    for (int r = 0; r < 16; ++r) ps += p0[r];
#pragma unroll
    for (int r = 0; r < 16; ++r) ps += p1[r];
    { auto rr = __builtin_amdgcn_permlane32_swap(__float_as_uint(ps), __float_as_uint(ps), false, false);
      ps = __uint_as_float(rr[0]) + __uint_as_float(rr[1]); }
    l_reg = l_reg * alpha + ps;
#define ATT_PK4(Pv, BASE, OUT) do { unsigned a0 = cvt_pk_bf16(Pv[BASE + 0], Pv[BASE + 1]), a1 = cvt_pk_bf16(Pv[BASE + 2], Pv[BASE + 3]); \
    unsigned b0 = cvt_pk_bf16(Pv[BASE + 4], Pv[BASE + 5]), b1 = cvt_pk_bf16(Pv[BASE + 6], Pv[BASE + 7]); \
    auto r0 = __builtin_amdgcn_permlane32_swap(a0, b0, false, false); auto r1 = __builtin_amdgcn_permlane32_swap(a1, b1, false, false); \
    u32x4 w = {r0[0], r1[0], r0[1], r1[1]}; OUT = __builtin_bit_cast(bf16x8, w); } while (0)
    ATT_PK4(p0, 0, pa0); ATT_PK4(p0, 8, pa1); ATT_PK4(p1, 0, pa2); ATT_PK4(p1, 8, pa3);
#undef ATT_PK4
}
__device__ __forceinline__ void attn_unit_c(LAS unsigned char* lds, const bf16_t* __restrict__ P, float* __restrict__ Of32, int ldo, const Cfg& c, int tid, int wid, int lane) {
    const int r32 = lane & 31, hi = lane >> 5;
    const LAS char* Kl = (const LAS char*)(lds + L_K);
    LAS float* wsf = (LAS float*)(lds + L_WS) + wid * 64;
    bf16x8 qr[4];
    { const bf16_t* Pq = P + (size_t)(c.qrow0 + wid * 32 + r32) * INW + c.qcol + hi * 8;
#pragma unroll
      for (int d0 = 0; d0 < 4; ++d0) qr[d0] = *(const bf16x8*)(Pq + d0 * 16); }
    const int vsr = tid >> 4, vsc = (tid & 15) * 8, ksr = tid >> 3, ksc = (tid & 7) * 8;
    const int vst0 = v_st(vsr, vsc), vst1 = v_st(32 + vsr, vsc);
    const int kst0 = ksr * 128 + ((ksc * 2) ^ ((ksr & 7) << 4));
    const int vb0 = (int)(unsigned)(size_t)(lds + L_V) + v_rd_base(lane);
    const int NT = 4 + c.nlat;
    const bf16_t* Pv = P + (size_t)vsr * INW + c.vcol + vsc; const bf16_t* Pk = P + (size_t)ksr * INW + c.kcol + ksc;
    bf16x8 vE0, vE1, kE, vO0, vO1, kO;
#define C_ROW(j) (((j) < 4) ? (c.ctxrow0 + 64 * (j)) : (c.latrow0 + 64 * ((j) - 4)))
#define C_SLOAD(v0, v1, k, j) do { const size_t _o = (size_t)C_ROW(j) * INW; v0 = *(const bf16x8*)(Pv + _o); v1 = *(const bf16x8*)(Pv + _o + (size_t)32 * INW); k = *(const bf16x8*)(Pk + _o); } while (0)
#define C_SWRITE(b, v0, v1, k) do { *(LAS bf16x8*)(lds + L_V + (b) * 16384 + vst0) = v0; *(LAS bf16x8*)(lds + L_V + (b) * 16384 + vst1) = v1; *(LAS bf16x8*)(lds + L_K + (b) * 16384 + kst0) = k; } while (0)
#define C_RESC(a) do { if (__any((a) < 1.f)) { if (hi == 0) wsf[r32] = (a); LDS_WAIT(); \
        _Pragma("unroll") for (int r = 0; r < 16; ++r) { const float _a = wsf[crow(r, hi)]; _Pragma("unroll") for (int d = 0; d < 4; ++d) o[d][r] *= _a; } LDS_WAIT(); } } while (0)
#define C_PV(vb) do { pv_one<0>(o[0], vb, pa0, pa1, pa2, pa3); pv_one<1>(o[1], vb, pa0, pa1, pa2, pa3); pv_one<2>(o[2], vb, pa0, pa1, pa2, pa3); pv_one<3>(o[3], vb, pa0, pa1, pa2, pa3); } while (0)
#define C_SB() __builtin_amdgcn_sched_barrier(0)
    float m_reg = -1e30f, l_reg = 0.f;
    f32x16 o[4];
#pragma unroll
    for (int d = 0; d < 4; ++d) o[d] = (f32x16){0, 0, 0, 0, 0, 0, 0, 0, 0, 0, 0, 0, 0, 0, 0, 0};
    f32x16 pA0, pA1, pB0, pB1; float mnA, mnB, alA, alB; bf16x8 pa0, pa1, pa2, pa3;
    C_SLOAD(vE0, vE1, kE, 0); C_SWRITE(0, vE0, vE1, kE); __syncthreads();
    qkt<64>(pA0, pA1, Kl, qr, r32, hi); c_partialSM(pA0, pA1, m_reg, mnA, alA);
    C_SLOAD(vO0, vO1, kO, 1); if (2 < NT) C_SLOAD(vE0, vE1, kE, 2);
    C_SWRITE(1, vO0, vO1, kO); __syncthreads();
    for (int j = 1; j + 1 < NT; j += 2) {
        C_SB(); qkt<64>(pB0, pB1, Kl + 16384, qr, r32, hi);
        c_finishSM(pA0, pA1, alA, l_reg, pa0, pa1, pa2, pa3); C_SB();
        C_SLOAD(vO0, vO1, kO, j + 2); C_SB();
        C_PV(vb0); c_partialSM(pB0, pB1, m_reg, mnB, alB);
        __syncthreads(); C_SWRITE(0, vE0, vE1, kE);
        C_RESC(alB); __syncthreads();
        C_SB(); qkt<64>(pA0, pA1, Kl, qr, r32, hi);
        c_finishSM(pB0, pB1, alB, l_reg, pa0, pa1, pa2, pa3); C_SB();
        if (j + 3 < NT) C_SLOAD(vE0, vE1, kE, j + 3); C_SB();
        C_PV(vb0 + 16384); c_partialSM(pA0, pA1, m_reg, mnA, alA);
        __syncthreads(); C_SWRITE(1, vO0, vO1, kO);
        C_RESC(alA); __syncthreads();
    }
    C_SB(); qkt<64>(pB0, pB1, Kl + 16384, qr, r32, hi);
    c_finishSM(pA0, pA1, alA, l_reg, pa0, pa1, pa2, pa3); C_SB();
    C_PV(vb0); c_partialSM(pB0, pB1, m_reg, mnB, alB);
    __syncthreads(); C_RESC(alB);
    c_finishSM(pB0, pB1, alB, l_reg, pa0, pa1, pa2, pa3); C_SB();
    C_PV(vb0 + 16384);
    (void)mnA; (void)mnB;
#undef C_ROW
#undef C_SLOAD
#undef C_SWRITE
#undef C_RESC
#undef C_PV
#undef C_SB
    if (hi == 0) wsf[32 + r32] = l_reg;
    LDS_WAIT();
    float rli[16];
#pragma unroll
    for (int r = 0; r < 16; ++r) rli[r] = 1.0f / wsf[32 + crow(r, hi)];
    LDS_WAIT();
    const int orow0 = c.qrow0 + wid * 32;
#pragma unroll
    for (int r = 0; r < 16; ++r) { float* op = Of32 + (size_t)(orow0 + crow(r, hi)) * ldo + c.ocol + r32;
#pragma unroll
        for (int d0 = 0; d0 < 4; ++d0) op[d0 * 32] = o[d0][r] * rli[r]; }
    __syncthreads();
}
}

#define XB_TMO      128
#define XB_XCNT(j)  (256  + 64 * (j))
#define XB_XSUB(j)  (1280 + 64 * (j))
#define XB_XGEN(j)  (2304 + 64 * (j))
#define XB_TOP      3328
#define XB_TOPGEN   3392
#define XCD_BAR_WORDS 3456
#define XB_SPIN_CAP (1u << 22)
__device__ __forceinline__ unsigned xb_ld(unsigned* p)              { return __hip_atomic_load(p, __ATOMIC_RELAXED, __HIP_MEMORY_SCOPE_AGENT); }
__device__ __forceinline__ unsigned xb_add(unsigned* p, unsigned v) { return __hip_atomic_fetch_add(p, v, __ATOMIC_RELAXED, __HIP_MEMORY_SCOPE_AGENT); }
__device__ __forceinline__ unsigned xb_xcc_id() { return (unsigned)__builtin_amdgcn_s_getreg((3 << 11) | 20) & 0xFu; }
#define XB_SPIN(cond, bar) do { unsigned _sp = 0; while (cond) { __builtin_amdgcn_s_sleep(1); \
    if ((++_sp & 255u) == 0u) { if (xb_ld(&(bar)[XB_TMO])) break; if (_sp > XB_SPIN_CAP) { atomicAdd(&(bar)[XB_TMO], 1u); break; } } } } while (0)
struct XcdBarrier { unsigned* bar; unsigned x; volatile LAS unsigned* st; };
__device__ __forceinline__ XcdBarrier xcd_barrier_post(unsigned* bar, volatile LAS unsigned* st) {
    XcdBarrier b; b.bar = bar; b.x = xb_xcc_id(); b.st = st;
    if (threadIdx.x == 0) (void)xb_add(&bar[XB_XCNT(b.x)], 1u);
    return b;
}
__device__ __forceinline__ void xcd_barrier_complete(unsigned* bar, unsigned x, unsigned& nloc, unsigned& nx) {
    const unsigned G = gridDim.x * gridDim.y * gridDim.z;
    unsigned sum, cnt, mine, sp = 0u;
    for (;;) {
        sum = 0u; cnt = 0u; mine = 0u;
#pragma unroll
        for (unsigned j = 0; j < 16; ++j) { const unsigned c = xb_ld(&bar[XB_XCNT(j)]); sum += c; cnt += (c > 0u) ? 1u : 0u; mine = (j == x) ? c : mine; }
        if (sum == G) break;
        __builtin_amdgcn_s_sleep(1);
        if ((++sp & 255u) == 0u) { if (xb_ld(&bar[XB_TMO])) break; if (sp > XB_SPIN_CAP) { atomicAdd(&bar[XB_TMO], 1u); break; } }
    }
    nloc = mine > 0u ? mine : 1u; nx = cnt > 0u ? cnt : 1u;
}
__device__ __forceinline__ void xcd_barrier(const XcdBarrier& b) {
    asm volatile("s_waitcnt vmcnt(0)" ::: "memory");
    __syncthreads();
    if (threadIdx.x == 0) {
        unsigned* bar = b.bar;
        __builtin_amdgcn_s_waitcnt(0);
        unsigned nloc = b.st[0], nx = b.st[1];
        if (nloc == 0u) { xcd_barrier_complete(bar, b.x, nloc, nx); b.st[0] = nloc; b.st[1] = nx; }
        const unsigned old = xb_add(&bar[XB_XSUB(b.x)], 1u);
        const unsigned gen = old / nloc;
        if (old + 1u == (gen + 1u) * nloc) {
            __builtin_amdgcn_fence(__ATOMIC_RELEASE, "agent");
            asm volatile("s_waitcnt vmcnt(0)" ::: "memory");
            const unsigned og = xb_add(&bar[XB_TOP], 1u);
            const unsigned tg = og / nx;
            if (og + 1u == (tg + 1u) * nx) xb_add(&bar[XB_TOPGEN], 1u);
            else XB_SPIN(xb_ld(&bar[XB_TOPGEN]) == tg, bar);
            __builtin_amdgcn_fence(__ATOMIC_ACQUIRE, "agent");
            xb_add(&bar[XB_XGEN(b.x)], 1u);
            asm volatile("s_waitcnt vmcnt(0)" ::: "memory");
        } else {
            XB_SPIN(xb_ld(&bar[XB_XGEN(b.x)]) == gen, bar);
            __builtin_amdgcn_fence(__ATOMIC_ACQUIRE, "agent");
            asm volatile("s_waitcnt vmcnt(0)" ::: "memory");
        }
    }
    __syncthreads();
}

struct Args {
    const float *x, *c, *ctx, *c_ctx, *ada_w, *ada_b, *norm1_g, *norm2_g, *w_in, *w_out, *na_q_norm, *na_k_norm, *na_rpb, *sw_q_norm, *sw_k_norm, *sw_sink,
                *df_q_norm, *df_k_norm, *df_lambda, *df_subln_g, *ffn_w1, *ffn_w3, *ffn_w2, *moe_router, *moe_w1, *moe_w3, *moe_w2;
    float* out; unsigned char* ws; int ph_lo, ph_hi;
};

__device__ __forceinline__ void tr_item(const float* __restrict__ W, int K, int N, bf16_t* __restrict__ WT, int mode, int item, int lane) {
    const int nblk = N >> 6, kb = item / nblk, nb = item - kb * nblk, k0 = kb * 32, n = nb * 64 + lane;
    const float* src = W + (size_t)k0 * N + n;
    float v[32];
#pragma unroll
    for (int i = 0; i < 32; ++i) v[i] = src[(size_t)i * N];
    int orow = n; if (mode) orow = ((n >> 4) << 5) + (n & 15) + (mode == 2 ? 16 : 0);
    u32x4* dst = (u32x4*)(WT + (size_t)orow * K + k0);
#pragma unroll
    for (int q = 0; q < 4; ++q) { u32x4 w; w.x = cvt_pk_bf16(v[8 * q], v[8 * q + 1]); w.y = cvt_pk_bf16(v[8 * q + 2], v[8 * q + 3]); w.z = cvt_pk_bf16(v[8 * q + 4], v[8 * q + 5]); w.w = cvt_pk_bf16(v[8 * q + 6], v[8 * q + 7]); dst[q] = w; }
}

typedef const __attribute__((address_space(4))) Args KArgs;
__device__ __forceinline__ KArgs* kargs() { KArgs* p = (KArgs*)__builtin_amdgcn_kernarg_segment_ptr(); asm volatile("" : "+s"(p)); return p; }
#define PH_BEGIN KArgs* A = kargs(); unsigned char* const ws = A->ws; unsigned* const ctl = (unsigned*)(ws + WS_CTL); (void)ctl; \
    int tid = threadIdx.x; asm volatile("" : "+v"(tid)); const int lane = tid & 63, wave = __builtin_amdgcn_readfirstlane(tid >> 6); const int gw = vcu * 8 + wave; (void)lane; (void)gw;

__global__ void __launch_bounds__(512, 2) mk_fwd(Args A_unused) {
    extern __shared__ __attribute__((aligned(16))) unsigned char lds_raw[];
    LAS unsigned char* lds = (LAS unsigned char*)lds_raw;
    volatile LAS unsigned* MISC = (volatile LAS unsigned*)(lds + MISC_OFF);
    const int G = gridDim.x; const int bx = blockIdx.x; const int vcu = (G % 8 == 0) ? (bx % 8) * (G / 8) + bx / 8 : bx;
    const int NGW = G * 8;
    for (int u = threadIdx.x; u < (LDS_BYTES - LDSCTL_OFF) / 4; u += 512) ((LAS unsigned*)(lds + LDSCTL_OFF))[u] = 0u;
    __syncthreads();
    XcdBarrier bar; bar.bar = nullptr; bar.x = 0; bar.st = nullptr;
    int lo, hi;
    { KArgs* A = kargs(); lo = A->ph_lo; hi = A->ph_hi; unsigned* ctl0 = (unsigned*)(A->ws + WS_CTL); bar.bar = ctl0 + CW_BAR;
      if (!MK_PER_PHASE) bar = xcd_barrier_post(ctl0 + CW_BAR, MISC + 8); }
#ifndef EN_MASK
#define EN_MASK 0xFFFFFFFFu
#endif
#define IN(k) (lo <= (k) && (k) < hi)
#define EN(b) ((EN_MASK >> (b)) & 1u)
#define SEAM(k) do { if (!MK_PER_PHASE) { if (IN(k) && IN((k) + 1)) xcd_barrier(bar); } } while (0)
#define WSP(T, off) ((T*)(ws + (off)))

    for (int rep = 0; rep < 1 + DUP_P0; ++rep)
    if (EN(0) && IN(0)) { PH_BEGIN
        if (rep) __syncthreads();
        LAS float* sv = (LAS float*)lds;
        LAS float* part = (LAS float*)(lds + 40960);
        for (int i = tid; i < 5 * D; i += 512) { const int v = i >> 11, k = i & (D - 1); const float xv = (v < 4) ? A->c[v * D + k] : A->c_ctx[k]; sv[i] = xv / (1.0f + __expf(-xv)); }
        __syncthreads();
        for (int it = vcu; it < 768; it += G) {
            const int L = it / 384, col0 = (it % 384) * 32, colx = col0 + (lane & 31), ks = lane >> 5;
            const float* wp = A->ada_w + (size_t)L * D * 12288 + colx;
            float acc[5] = {0.f, 0.f, 0.f, 0.f, 0.f};
            for (int kk = 0; kk < 256; kk += 16) {
                float a[8];
#pragma unroll
                for (int q = 0; q < 8; ++q) a[q] = wp[(size_t)(256 * wave + kk + 2 * q + ks) * 12288];
#pragma unroll
                for (int q = 0; q < 8; ++q) { const int k = 256 * wave + kk + 2 * q + ks;
#pragma unroll
                    for (int v = 0; v < 5; ++v) acc[v] += sv[v * D + k] * a[q]; }
            }
#pragma unroll
            for (int v = 0; v < 5; ++v) { { auto rr = __builtin_amdgcn_permlane32_swap(__float_as_uint(acc[v]), __float_as_uint(acc[v]), false, false); acc[v] = __uint_as_float(rr[0]) + __uint_as_float(rr[1]); } if (lane < 32) part[(wave * 5 + v) * 32 + lane] = acc[v]; }
            __syncthreads();
            if (tid < 160) { const int v = tid >> 5, cc = tid & 31; float s = 0.f;
#pragma unroll
                for (int w = 0; w < 8; ++w) s += part[(w * 5 + v) * 32 + cc];
                WSP(float, WS_MOD)[(size_t)(L * 5 + v) * 12288 + col0 + cc] = s + A->ada_b[L * 12288 + col0 + cc]; }
            __syncthreads();
        }
        constexpr int I_IN = 5120, I_OUT = 2048, I_FF = 5632;
        constexpr int NIT = 2 * I_IN + 2 * I_OUT + 3 * I_FF + 24 * I_FF;
        for (int it = gw; it < NIT; it += NGW) {
            int r = it;
            if (r < 2 * I_IN) { const int L = r / I_IN; tr_item(A->w_in + (size_t)L * D * INW, D, INW, WSP(bf16_t, WS_WIN) + (size_t)L * INW * D, 0, r % I_IN, lane); continue; } r -= 2 * I_IN;
            if (r < 2 * I_OUT) { const int L = r / I_OUT; tr_item(A->w_out + (size_t)L * D * D, D, D, WSP(bf16_t, WS_WOUT) + (size_t)L * D * D, 0, r % I_OUT, lane); continue; } r -= 2 * I_OUT;
            if (r < I_FF) { tr_item(A->ffn_w1, D, FF, WSP(bf16_t, WS_W13), 1, r, lane); continue; } r -= I_FF;
            if (r < I_FF) { tr_item(A->ffn_w3, D, FF, WSP(bf16_t, WS_W13), 2, r, lane); continue; } r -= I_FF;
            if (r < I_FF) { tr_item(A->ffn_w2, FF, D, WSP(bf16_t, WS_W2), 0, r, lane); continue; } r -= I_FF;
            const int j = r / I_FF, ty = j >> 3, e = j & 7, rr = r % I_FF;
            if (ty == 0) tr_item(A->moe_w1 + (size_t)e * D * FF, D, FF, WSP(bf16_t, WS_MW13) + (size_t)e * FF2 * D, 1, rr, lane);
            else if (ty == 1) tr_item(A->moe_w3 + (size_t)e * D * FF, D, FF, WSP(bf16_t, WS_MW13) + (size_t)e * FF2 * D, 2, rr, lane);
            else tr_item(A->moe_w2 + (size_t)e * FF * D, FF, D, WSP(bf16_t, WS_MW2) + (size_t)e * D * FF, 0, rr, lane);
        }
    }
    SEAM(0);

#pragma unroll 1
    for (int L = 0; L < 2; ++L) {
        const int pb = 1 + 16 * L;
#define modL (WSP(float, WS_MOD) + (size_t)L * 5 * 12288)
        const int MROWS = (L == 0) ? R_ALL : LAT;
        if (EN(1) && IN(pb + 0)) { PH_BEGIN
            const float* gain = A->norm1_g + L * D;
            for (int m = gw; m < R_ALL; m += NGW) {
                const bool isctx = m >= LAT; const int b = isctx ? 4 : (m >> 12);
                const float* xr = (L == 0) ? (isctx ? A->ctx + (size_t)(m - LAT) * D : A->x + (size_t)m * D) : (isctx ? WSP(float, WS_XC) + (size_t)(m - LAT) * D : A->out + (size_t)m * D);
                const float* sh = modL + (size_t)b * 12288; const float* sc = sh + D;
                f32x4 v[8]; float ss = 0.f;
#pragma unroll
                for (int j = 0; j < 8; ++j) { v[j] = *(const f32x4*)(xr + 256 * j + 4 * lane); ss += (v[j].x * v[j].x + v[j].y * v[j].y) + (v[j].z * v[j].z + v[j].w * v[j].w); }
                const float rinv = rsqrtf(wave_sum(ss) * (1.0f / D) + NORM_EPS);
                bf16_t* orow = WSP(bf16_t, WS_H) + (size_t)m * D;
#pragma unroll
                for (int j = 0; j < 8; ++j) { const int cidx = 256 * j + 4 * lane; const f32x4 gq = *(const f32x4*)(gain + cidx), s4 = *(const f32x4*)(sc + cidx), h4 = *(const f32x4*)(sh + cidx);
                    const f32x4 y = v[j] * rinv * gq * (1.0f + s4) + h4; u32x2 w; w.x = cvt_pk_bf16(y.x, y.y); w.y = cvt_pk_bf16(y.z, y.w); *(u32x2*)(orow + cidx) = w; }
            }
        }
        SEAM(pb + 0);
        if (EN(2) && IN(pb + 1)) { PH_BEGIN
            pg8::Gemm g{WSP(bf16_t, WS_H), WSP(bf16_t, WS_WIN) + (size_t)L * INW * D, INW, D, nullptr}; pg8::StaticOrder S; S.init(R_ALL, INW, G, bx);
            pg8::EpiBf16 E{WSP(bf16_t, WS_P), INW};
            pg8::gemm_phase<pg8::EpiBf16, pg8::StaticOrder, false>(lds, g, S, E);
        }
        SEAM(pb + 1);
        if (EN(3) && IN(pb + 2)) { PH_BEGIN
            const int d1 = (lane & 31) + 64 * (lane >> 5), d2 = d1 + 32;
            const int li = lane & 31, e1 = (li & 15) + 32 * (li >> 4), e2 = e1 + 16;
            const float gaq1 = A->na_q_norm[L * 128 + d1], gaq2 = A->na_q_norm[L * 128 + d2], gak1 = A->na_k_norm[L * 128 + d1], gak2 = A->na_k_norm[L * 128 + d2];
            const float gbq1 = A->sw_q_norm[L * 128 + d1], gbq2 = A->sw_q_norm[L * 128 + d2], gbk1 = A->sw_k_norm[L * 128 + d1], gbk2 = A->sw_k_norm[L * 128 + d2];
            const float gcq1 = A->df_q_norm[L * 64 + e1], gcq2 = A->df_q_norm[L * 64 + e2], gck1 = A->df_k_norm[L * 64 + e1], gck2 = A->df_k_norm[L * 64 + e2];
            const float ifB = exp2f(-(float)(2 * (lane & 31)) * (1.0f / 64.0f) * 13.287712379549449f);
            const float ifC = exp2f(-(float)(2 * (li & 15)) * (1.0f / 32.0f) * 13.287712379549449f);
            for (int m = gw; m < R_ALL; m += NGW) {
                const bool rope = m < LAT; const int t = m & (SEQ - 1);
                float csB = 1.f, snB = 0.f, csC = 1.f, snC = 0.f;
                if (rope) { const float posB = (lane < 32) ? (float)(t >> 6) : (float)(t & 63); sincosf(posB * ifB, &snB, &csB);
                            const float posC = (li < 16) ? (float)(t >> 6) : (float)(t & 63); sincosf(posC * ifC, &snC, &csC); }
                bf16_t* prow = WSP(bf16_t, WS_P) + (size_t)m * INW;
#define NR128(colbase, g1, g2, ROPE) do { bf16_t* p_ = prow + (colbase); const float x1 = bf2f(p_[d1]), x2 = bf2f(p_[d2]); \
        const float rinv = rsqrtf(wave_sum(x1 * x1 + x2 * x2) * (1.0f / 128.0f) + NORM_EPS); const float y1 = x1 * rinv * (g1), y2 = x2 * rinv * (g2); \
        float o1 = y1, o2 = y2; if (ROPE) { o1 = y1 * csB - y2 * snB; o2 = y2 * csB + y1 * snB; } p_[d1] = f2bf(o1); p_[d2] = f2bf(o2); } while (0)
                for (int h = 0; h < 6; ++h) NR128(C_QA + h * 128, gaq1, gaq2, false);
                for (int h = 0; h < 6; ++h) NR128(C_KA + h * 128, gak1, gak2, false);
                for (int h = 0; h < 6; ++h) NR128(C_QB + h * 128, gbq1, gbq2, rope);
                for (int h = 0; h < 2; ++h) NR128(C_KB + h * 128, gbk1, gbk2, rope);
#undef NR128
#define NR64(colbase, g1, g2) do { bf16_t* p_ = prow + (colbase) + (lane >> 5) * 64; const float x1 = bf2f(p_[e1]), x2 = bf2f(p_[e2]); float s_ = x1 * x1 + x2 * x2; \
        s_ = half_sum32(s_); \
        const float rinv = rsqrtf(s_ * (1.0f / 64.0f) + NORM_EPS); const float y1 = x1 * rinv * (g1), y2 = x2 * rinv * (g2); \
        float o1 = y1, o2 = y2; if (rope) { o1 = y1 * csC - y2 * snC; o2 = y2 * csC + y1 * snC; } p_[e1] = f2bf(o1); p_[e2] = f2bf(o2); } while (0)
                for (int h = 0; h < 4; ++h) NR64(C_QC + h * 128, gcq1, gcq2);
                for (int h = 0; h < 4; ++h) NR64(C_KC + h * 128, gck1, gck2);
#undef NR64
            }
        }
        SEAM(pb + 2);
        for (int rep = 0; rep < 1 + DUP_ATT; ++rep)
        if (EN(4) && IN(pb + 3)) { PH_BEGIN
            const int nC = 512 + (L == 0 ? 32 : 0), nAB = 768 + (L == 0 ? 48 : 0);
            for (;;) {
                __syncthreads();
                if (tid == 0) MISC[0] = atomicAdd(ctl + CW_Q + 64 * (L * 2 + 0 + 4 * rep), 1u);
                __syncthreads();
                const int idx = (int)MISC[0];
                if (idx >= nC) break;
                att::Cfg c; c.mode = 0; c.sink2 = -1e30f; c.rpb = nullptr; c.lat0 = 0;
                int b, vh;
                if (idx < 512) { b = idx >> 7; vh = (idx >> 4) & 7; c.qb = idx & 15; c.qrow0 = b * SEQ + 256 * c.qb; c.nlat = 64; }
                else { const int k = idx - 512; b = k >> 3; vh = k & 7; c.qb = 0; c.qrow0 = LAT + b * CTXL; c.nlat = 0; }
                c.qcol = C_QC + vh * 64; c.kcol = C_KC + vh * 64; c.vcol = C_VC + (vh >> 1) * 128; c.ctxrow0 = LAT + b * CTXL; c.latrow0 = b * SEQ; c.ocol = vh * 128;
                att::attn_unit_c(lds, WSP(bf16_t, WS_P), WSP(float, WS_OC), 1024, c, tid, wave, lane);
            }
            for (;;) {
                __syncthreads();
                if (tid == 0) MISC[0] = atomicAdd(ctl + CW_Q + 64 * (L * 2 + 1 + 4 * rep), 1u);
                __syncthreads();
                const int idx = (int)MISC[0];
                if (idx >= nAB) break;
                att::Cfg c; c.sink2 = -1e30f; c.rpb = nullptr;
                int b, h, ty;
                if (idx < 384) { ty = 0; const int gq = idx >> 4; b = gq / 6; h = gq % 6; c.qb = idx & 15; }
                else if (idx < 768) { const int k = idx - 384; ty = 1; const int gq = k >> 4; b = gq / 6; h = gq % 6; c.qb = k & 15; }
                else { const int k = idx - 768; ty = (k < 24) ? 2 : 3; const int kk = (k < 24) ? k : k - 24; b = kk / 6; h = kk % 6; c.qb = 0; }
                c.ctxrow0 = LAT + b * CTXL; c.latrow0 = b * SEQ;
                if (ty == 0) { c.qrow0 = b * SEQ + 256 * c.qb; c.qcol = C_QA + h * 128; c.kcol = C_KA + h * 128; c.vcol = C_VA + h * 128; c.ocol = h * 128; c.mode = 1;
                    const int ra = 4 * c.qb - 4, rb = 4 * c.qb - 1; c.lat0 = ra < 0 ? 0 : (ra > 56 ? 56 : ra); const int last = (rb < 0 ? 0 : (rb > 56 ? 56 : rb)) + 7; c.nlat = last - c.lat0 + 1;
                    c.rpb = A->na_rpb + (size_t)(L * 6 + h) * 465; }
                else if (ty == 1) { c.qrow0 = b * SEQ + 256 * c.qb; c.qcol = C_QB + h * 128; c.kcol = C_KB + (h / 3) * 128; c.vcol = C_VB + (h / 3) * 128; c.ocol = 768 + h * 128; c.mode = 2;
                    const int ja = 4 * c.qb - 2, jb = 4 * c.qb + 6; c.lat0 = ja < 0 ? 0 : ja; c.nlat = (jb > 64 ? 64 : jb) - c.lat0; c.sink2 = A->sw_sink[L * 6 + h] * LOG2E; }
                else if (ty == 2) { c.qrow0 = LAT + b * CTXL; c.qcol = C_QA + h * 128; c.kcol = C_KA + h * 128; c.vcol = C_VA + h * 128; c.ocol = h * 128; c.mode = 0; c.lat0 = 0; c.nlat = 0; }
                else { c.qrow0 = LAT + b * CTXL; c.qcol = C_QB + h * 128; c.kcol = C_KB + (h / 3) * 128; c.vcol = C_VB + (h / 3) * 128; c.ocol = 768 + h * 128; c.mode = 0; c.lat0 = 0; c.nlat = 0; c.sink2 = A->sw_sink[L * 6 + h] * LOG2E; }
                att::attn_unit<128, false>(lds, WSP(bf16_t, WS_P), WSP(bf16_t, WS_O), nullptr, D, c, tid, wave, lane);
            }
        }
        SEAM(pb + 3);
        if (EN(5) && IN(pb + 4)) { PH_BEGIN
            const float* dl = A->df_lambda + L * 256;
            const float s1 = wave_sum(dl[lane] * dl[64 + lane]), s2 = wave_sum(dl[128 + lane] * dl[192 + lane]);
            const float lam_init = 0.8f - 0.6f * expf(-0.3f * (float)L);
            const float lam = expf(s1) - expf(s2) + lam_init, post = 1.0f - lam_init;
            const int h = lane >> 4, d8 = (lane & 15) * 8;
            const f32x4 g0 = *(const f32x4*)(A->df_subln_g + L * 128 + d8), g1 = *(const f32x4*)(A->df_subln_g + L * 128 + d8 + 4);
            for (int m = gw; m < R_ALL; m += NGW) {
                if (L == 1 && m >= LAT) break;
                const float* o0 = WSP(float, WS_OC) + (size_t)m * 1024 + (2 * h) * 128 + d8; const float* o1 = o0 + 128;
                const f32x4 a0 = *(const f32x4*)o0, a1 = *(const f32x4*)(o0 + 4), b0 = *(const f32x4*)o1, b1 = *(const f32x4*)(o1 + 4);
                const f32x4 x0 = a0 - lam * b0, x1 = a1 - lam * b1;
                float ss = (x0.x * x0.x + x0.y * x0.y) + (x0.z * x0.z + x0.w * x0.w) + (x1.x * x1.x + x1.y * x1.y) + (x1.z * x1.z + x1.w * x1.w);
                ss += lane_xor<1>(ss); ss += lane_xor<2>(ss); ss += lane_xor<4>(ss); ss += lane_xor<8>(ss);
                const float rinv = rsqrtf(ss * (1.0f / 128.0f) + NORM_EPS) * post;
                const f32x4 y0 = x0 * rinv * g0, y1 = x1 * rinv * g1;
                u32x4 w; w.x = cvt_pk_bf16(y0.x, y0.y); w.y = cvt_pk_bf16(y0.z, y0.w); w.z = cvt_pk_bf16(y1.x, y1.y); w.w = cvt_pk_bf16(y1.z, y1.w);
                *(u32x4*)(WSP(bf16_t, WS_O) + (size_t)m * D + 1536 + h * 128 + d8) = w;
            }
        }
        SEAM(pb + 4);
        if (EN(6) && IN(pb + 5)) { PH_BEGIN
            pg8::Gemm g{WSP(bf16_t, WS_O), WSP(bf16_t, WS_WOUT) + (size_t)L * D * D, D, D, nullptr}; pg8::StaticOrder S; S.init(MROWS, D, G, bx);
            pg8::EpiResGate E{(L == 0) ? A->x : A->out, (L == 0) ? A->ctx : WSP(float, WS_XC), A->out, WSP(float, WS_XC), modL + 2 * D};
            pg8::gemm_phase<pg8::EpiResGate, pg8::StaticOrder, false>(lds, g, S, E);
        }
        SEAM(pb + 5);
        if (EN(7) && IN(pb + 6)) { PH_BEGIN
            const float* gain = A->norm2_g + L * D;
            LAS float* RT = (LAS float*)lds;
            if (L == 1) { for (int i = tid; i < D * NE; i += 512) RT[(i & 7) * D + (i >> 3)] = A->moe_router[i]; __syncthreads(); }
            for (int m = gw; m < MROWS; m += NGW) {
                const bool isctx = m >= LAT; const int b = isctx ? 4 : (m >> 12);
                const float* xr = isctx ? WSP(float, WS_XC) + (size_t)(m - LAT) * D : A->out + (size_t)m * D;
                const float* sh = modL + (size_t)b * 12288 + 3 * D; const float* sc = sh + D;
                f32x4 v[8]; float ss = 0.f;
#pragma unroll
                for (int j = 0; j < 8; ++j) { v[j] = *(const f32x4*)(xr + 256 * j + 4 * lane); ss += (v[j].x * v[j].x + v[j].y * v[j].y) + (v[j].z * v[j].z + v[j].w * v[j].w); }
                const float rinv = rsqrtf(wave_sum(ss) * (1.0f / D) + NORM_EPS);
                bf16_t* orow = WSP(bf16_t, WS_H) + (size_t)m * D;
#pragma unroll
                for (int j = 0; j < 8; ++j) { const int cidx = 256 * j + 4 * lane; const f32x4 gq = *(const f32x4*)(gain + cidx), s4 = *(const f32x4*)(sc + cidx), h4 = *(const f32x4*)(sh + cidx);
                    v[j] = v[j] * rinv * gq * (1.0f + s4) + h4; u32x2 w; w.x = cvt_pk_bf16(v[j].x, v[j].y); w.y = cvt_pk_bf16(v[j].z, v[j].w); *(u32x2*)(orow + cidx) = w; }
                if (L == 1) {
                    float lg[8];
#pragma unroll
                    for (int e = 0; e < 8; ++e) { float s = 0.f;
#pragma unroll
                        for (int j = 0; j < 8; ++j) { const f32x4 r4 = *(const LAS f32x4*)(RT + e * D + 256 * j + 4 * lane); s += (v[j].x * r4.x + v[j].y * r4.y) + (v[j].z * r4.z + v[j].w * r4.w); }
                        lg[e] = wave_sum(s); }
                    int e0 = 0; float b0 = lg[0];
#pragma unroll
                    for (int e = 1; e < 8; ++e) if (lg[e] > b0) { b0 = lg[e]; e0 = e; }
                    int e1 = -1; float b1 = -3.0e38f;
#pragma unroll
                    for (int e = 0; e < 8; ++e) if (e != e0 && lg[e] > b1) { b1 = lg[e]; e1 = e; }
                    const float ex = expf(b1 - b0), p0 = 1.0f / (1.0f + ex), p1 = ex / (1.0f + ex);
                    if (lane == 0) { WSP(int, WS_ROUTE_E)[m] = e0 | (e1 << 8); WSP(f32x2, WS_ROUTE_P)[m] = (f32x2){p0, p1}; }
                }
            }
            if (L == 1) __syncthreads();
        }
        SEAM(pb + 6);
        if (L == 0) {
            if (EN(8) && IN(pb + 7)) { PH_BEGIN
                pg8::Gemm g{WSP(bf16_t, WS_H), WSP(bf16_t, WS_W13), FF2, D, nullptr}; pg8::StaticOrder S; S.init(R_ALL, FF2, G, bx);
                pg8::EpiSwiGLU E{WSP(bf16_t, WS_G)};
                pg8::gemm_phase<pg8::EpiSwiGLU, pg8::StaticOrder, false>(lds, g, S, E);
            }
            SEAM(pb + 7);
            if (EN(9) && IN(pb + 8)) { PH_BEGIN
                pg8::Gemm g{WSP(bf16_t, WS_G), WSP(bf16_t, WS_W2), D, FF, nullptr}; pg8::StaticOrder S; S.init(R_ALL, D, G, bx);
                pg8::EpiResGate E{A->out, WSP(float, WS_XC), A->out, WSP(float, WS_XC), modL + 5 * D};
                pg8::gemm_phase<pg8::EpiResGate, pg8::StaticOrder, false>(lds, g, S, E);
            }
            SEAM(pb + 8);
        } else {
            if (EN(10) && IN(pb + 7)) { PH_BEGIN
                LAS int* cnt = (LAS int*)lds;
                LAS int* tot = (LAS int*)(lds + 16384);
                int myc[8] = {0, 0, 0, 0, 0, 0, 0, 0};
                for (int i = 0; i < 32; ++i) { const int ee = WSP(int, WS_ROUTE_E)[tid * 32 + i]; const int a = ee & 255, b2 = ee >> 8;
#pragma unroll
                    for (int e = 0; e < 8; ++e) myc[e] += (a == e) + (b2 == e); }
#pragma unroll
                for (int e = 0; e < 8; ++e) cnt[tid * 8 + e] = myc[e];
                __syncthreads();
                {
                    int loc[8]; int s = 0;
#pragma unroll
                    for (int q = 0; q < 8; ++q) { loc[q] = cnt[(lane * 8 + q) * 8 + wave]; s += loc[q]; }
                    LAS int* wsum = (LAS int*)(lds + 20480) + wave * 64;
                    wsum[lane] = s; LDS_WAIT();
                    int run = 0, incl = 0;
                    for (int q = 0; q < 64; ++q) { const int t = wsum[q]; if (q < lane) run += t; incl += t; }
#pragma unroll
                    for (int q = 0; q < 8; ++q) { cnt[(lane * 8 + q) * 8 + wave] = run; run += loc[q]; }
                    if (lane == 63) tot[wave] = incl;
                }
                __syncthreads();
                if (tid == 0) { int off = 0; for (int e = 0; e < 8; ++e) { tot[8 + e] = off; off += (tot[e] + 255) & ~255; } tot[16] = off >> 8; }
                __syncthreads();
                {
                    int tmod = tid; while (tmod >= G) tmod -= G;
                    if (tmod == bx) {
                        int base[8];
#pragma unroll
                        for (int e = 0; e < 8; ++e) base[e] = tot[8 + e] + cnt[tid * 8 + e];
                        for (int i = 0; i < 32; ++i) { const int t = tid * 32 + i; const int ee = WSP(int, WS_ROUTE_E)[t]; const int a = ee & 255, b2 = ee >> 8; int sa = 0, sb = 0;
#pragma unroll
                            for (int e = 0; e < 8; ++e) { if (a == e) { sa = base[e]; base[e] += 1; } if (b2 == e) { sb = base[e]; base[e] += 1; } }
                            WSP(int, WS_GROW)[sa] = t; WSP(int, WS_GROW)[sb] = t; WSP(int, WS_SLOT_OF)[2 * t] = sa; WSP(int, WS_SLOT_OF)[2 * t + 1] = sb; }
                    }
                }
                if (bx == 0) {
                    for (int e = 0; e < 8; ++e) { const int n = tot[e], np = (n + 255) & ~255, off = tot[8 + e];
                        for (int s = n + tid; s < np; s += 512) WSP(int, WS_GROW)[off + s] = 0;
                        for (int p = tid; p < (np >> 8); p += 512) WSP(int, WS_PANE)[(off >> 8) + p] = e; }
                    if (tid == 0) WSP(int, WS_PANE)[255] = tot[16];
                }
                __syncthreads();
            }
            SEAM(pb + 7);
            if (EN(11) && IN(pb + 8)) { PH_BEGIN
                pg8::Gemm g{WSP(bf16_t, WS_H), WSP(bf16_t, WS_MW13), FF2, D, WSP(int, WS_GROW)}; pg8::MoeOrder S{__hip_atomic_load(WSP(int, WS_PANE) + 255, __ATOMIC_RELAXED, __HIP_MEMORY_SCOPE_AGENT), FF2 / 256, G, bx, WSP(int, WS_PANE)};
                pg8::EpiSwiGLU E{WSP(bf16_t, WS_G)};
                pg8::gemm_phase<pg8::EpiSwiGLU, pg8::MoeOrder, true>(lds, g, S, E);
            }
            SEAM(pb + 8);
            if (EN(12) && IN(pb + 9)) { PH_BEGIN
                pg8::Gemm g{WSP(bf16_t, WS_G), WSP(bf16_t, WS_MW2), D, FF, nullptr}; pg8::MoeOrder S{__hip_atomic_load(WSP(int, WS_PANE) + 255, __ATOMIC_RELAXED, __HIP_MEMORY_SCOPE_AGENT), D / 256, G, bx, WSP(int, WS_PANE)};
                pg8::EpiF32 E{WSP(float, WS_Y), D};
                pg8::gemm_phase<pg8::EpiF32, pg8::MoeOrder, false>(lds, g, S, E);
            }
            SEAM(pb + 9);
            if (EN(13) && IN(pb + 10)) { PH_BEGIN
                for (int m = gw; m < LAT; m += NGW) {
                    const int b = m >> 12; const float* gt = modL + (size_t)b * 12288 + 5 * D;
                    const int s0 = WSP(int, WS_SLOT_OF)[2 * m], s1 = WSP(int, WS_SLOT_OF)[2 * m + 1]; const f32x2 pp = WSP(f32x2, WS_ROUTE_P)[m];
                    const int ee = WSP(int, WS_ROUTE_E)[m]; const bool swap = (ee >> 8) < (ee & 255);
                    const float* ya = WSP(float, WS_Y) + (size_t)(swap ? s1 : s0) * D; const float* yb = WSP(float, WS_Y) + (size_t)(swap ? s0 : s1) * D; const float pa = swap ? pp.y : pp.x, pbb = swap ? pp.x : pp.y;
                    float* xr = A->out + (size_t)m * D;
#pragma unroll
                    for (int j = 0; j < 8; ++j) { const int cidx = 256 * j + 4 * lane; const f32x4 xv = *(const f32x4*)(xr + cidx), a4 = *(const f32x4*)(ya + cidx), b4 = *(const f32x4*)(yb + cidx), g4 = *(const f32x4*)(gt + cidx);
                        *(f32x4*)(xr + cidx) = xv + g4 * (pa * a4 + pbb * b4); }
                }
            }
        }
    }
#undef modL
#undef IN
#undef SEAM
}

extern "C" void kernel_launch(void* const* d_in, const int* in_sizes, int n_in, void* d_out, int out_size, void* d_ws, size_t ws_size, hipStream_t stream) {
    static int grid = 0;
    if (grid == 0) {
        if (n_in != 27 || out_size != LAT * D || ws_size < WS_END) { fprintf(stderr, "kernel_launch: unexpected shapes (n_in %d out %d ws %zu need %zu)\n", n_in, out_size, ws_size, (size_t)WS_END); grid = -1; return; }
        int dev = 0, cus = 0, per_cu = 0;
        if (hipGetDevice(&dev) != hipSuccess || hipDeviceGetAttribute(&cus, hipDeviceAttributeMultiprocessorCount, dev) != hipSuccess) { grid = -1; return; }
        if (hipFuncSetAttribute((const void*)mk_fwd, hipFuncAttributeMaxDynamicSharedMemorySize, LDS_BYTES) != hipSuccess) { fprintf(stderr, "kernel_launch: hipFuncSetAttribute failed\n"); grid = -1; return; }
        if (hipOccupancyMaxActiveBlocksPerMultiprocessor(&per_cu, (const void*)mk_fwd, 512, LDS_BYTES) != hipSuccess || per_cu < 1) fprintf(stderr, "kernel_launch: occupancy query reports %d\n", per_cu);
        (void)hipGetLastError();
        grid = cus;
    }
    if (grid < 0) return;
    if (hipMemsetAsync((char*)d_ws + WS_CTL, 0, CTL_ZERO_BYTES, stream) != hipSuccess) return;
    Args a{};
    const float** ap = (const float**)&a;
    for (int i = 0; i < 27; ++i) ap[i] = (const float*)d_in[i];
    a.out = (float*)d_out; a.ws = (unsigned char*)d_ws;
#if MK_PER_PHASE
    static const int ids[] = {0, 1, 2, 3, 4, 5, 6, 7, 8, 9, 17, 18, 19, 20, 21, 22, 23, 24, 25, 26, 27};
    for (int k = 0; k < (int)(sizeof(ids) / sizeof(ids[0])); ++k) { a.ph_lo = ids[k]; a.ph_hi = ids[k] + 1; hipLaunchKernelGGL(mk_fwd, dim3(grid), dim3(512), LDS_BYTES, stream, a); }
#else
    a.ph_lo = 0; a.ph_hi = 64;
    hipLaunchKernelGGL(mk_fwd, dim3(grid), dim3(512), LDS_BYTES, stream, a);
#endif
    const hipError_t le = hipPeekAtLastError();
    if (le != hipSuccess) fprintf(stderr, "kernel_launch: launch failed: %s\n", hipGetErrorName(le));
}
```
